# Optimizing an MI355X kernel written in HIP

```python
import math
import jax
import jax.numpy as jnp
from jax import lax
import numpy as np

D_MODEL = 1024
BATCH = 4
SEQ = 8192
DEPTH = 2

N_BRANCH = 4
BRANCH_WIDTH = 256
MLA_HEADS = 4
MLA_Q_LORA = 384
MLA_KV_LORA = 128
MLA_NOPE = 64
MLA_ROPE = 32
MLA_V = 64
FNET_GROUPS = 4
FNET_GROUP_DIM = 64
DIFF_HEADS = 4
DIFF_HEAD_DIM = 32
HGRN_HEADS = 4
HGRN_KEY_DIM = 64
HGRN_VAL_DIM = 64
HGRN_CHUNK = 64
D_FF = -(-8 * D_MODEL // (3 * 256)) * 256

ROPE_THETA = 10000.0
Q_BLOCK = 128
EPS = 1e-6

IN_WIDTHS = (
    MLA_Q_LORA,
    MLA_KV_LORA,
    MLA_ROPE,
    FNET_GROUPS * FNET_GROUP_DIM,
    2 * DIFF_HEADS * DIFF_HEAD_DIM,
    2 * DIFF_HEADS * DIFF_HEAD_DIM,
    DIFF_HEADS * 2 * DIFF_HEAD_DIM,
    HGRN_HEADS * HGRN_KEY_DIM,
    HGRN_HEADS * HGRN_VAL_DIM,
    HGRN_HEADS * HGRN_KEY_DIM,
    HGRN_HEADS * HGRN_KEY_DIM,
    HGRN_HEADS * HGRN_VAL_DIM,
    N_BRANCH * D_MODEL,
)
IN_TOTAL = sum(IN_WIDTHS)

kernel_name = 'hybrid_mla_fnet_diffattn_hgrn2_encoder'


def rmsnorm(x, g):
    xf = x.astype(jnp.float32)
    y = xf * lax.rsqrt(jnp.mean(xf * xf, axis=-1, keepdims=True) + EPS)
    return (y * g.astype(jnp.float32)).astype(x.dtype)


def split_cols(z, widths):
    offsets = [int(o) for o in np.cumsum(widths)[:-1]]
    return jnp.split(z, offsets, axis=-1)


def rope_tables(seq_len, dim):
    inv_freq = 1.0 / (ROPE_THETA ** (jnp.arange(0, dim, 2, dtype=jnp.float32) / dim))
    ang = jnp.arange(seq_len, dtype=jnp.float32)[:, None] * inv_freq[None, :]
    return jnp.cos(ang), jnp.sin(ang)


def apply_rope(t, cos, sin):
    tf = t.astype(jnp.float32)
    t1, t2 = jnp.split(tf, 2, axis=-1)
    c = cos[None, :, None, :]
    s = sin[None, :, None, :]
    return jnp.concatenate([t1 * c - t2 * s, t1 * s + t2 * c], axis=-1).astype(t.dtype)


def to_query_blocks(t):
    b, s, h, d = t.shape
    return t.reshape(b, s // Q_BLOCK, Q_BLOCK, h, d).transpose(1, 0, 2, 3, 4)


def from_query_blocks(t):
    nb, b, qb, h, d = t.shape
    return t.transpose(1, 0, 2, 3, 4).reshape(b, nb * qb, h, d)


def block_softmax_attention(q, k, v, scale):
    def one_block(qb):
        s = jnp.einsum('bqhd,bkhd->bhqk', qb, k).astype(jnp.float32) * scale
        p = jax.nn.softmax(s, axis=-1)
        return jnp.einsum('bhqk,bkhd->bqhd', p.astype(v.dtype), v)
    return from_query_blocks(lax.map(one_block, to_query_blocks(q)))


def block_diff_attention(q1, q2, k1, k2, v, lam, scale):
    def one_block(qs):
        qb1, qb2 = qs
        s1 = jnp.einsum('bqhd,bkhd->bhqk', qb1, k1).astype(jnp.float32) * scale
        s2 = jnp.einsum('bqhd,bkhd->bhqk', qb2, k2).astype(jnp.float32) * scale
        p = jax.nn.softmax(s1, axis=-1) - lam * jax.nn.softmax(s2, axis=-1)
        return jnp.einsum('bhqk,bkhd->bqhd', p.astype(v.dtype), v)
    return from_query_blocks(lax.map(one_block, (to_query_blocks(q1), to_query_blocks(q2))))


def mla_mixer(c_q, c_kv, k_rope, g_qa, w_uq, g_kva, w_ukv, g_qn, g_kn, cos, sin):
    b, s, _ = c_q.shape
    qk_dim = MLA_NOPE + MLA_ROPE
    q = (rmsnorm(c_q, g_qa) @ w_uq).reshape(b, s, MLA_HEADS, qk_dim)
    kv = (rmsnorm(c_kv, g_kva) @ w_ukv).reshape(b, s, MLA_HEADS, MLA_NOPE + MLA_V)
    k_nope, v = jnp.split(kv, [MLA_NOPE], axis=-1)
    k_pe = jnp.broadcast_to(k_rope[:, :, None, :], (b, s, MLA_HEADS, MLA_ROPE))
    k = jnp.concatenate([k_nope, k_pe], axis=-1)
    q = rmsnorm(q, g_qn)
    k = rmsnorm(k, g_kn)
    q = jnp.concatenate([q[..., :MLA_NOPE], apply_rope(q[..., MLA_NOPE:], cos, sin)], axis=-1)
    k = jnp.concatenate([k[..., :MLA_NOPE], apply_rope(k[..., MLA_NOPE:], cos, sin)], axis=-1)
    o = block_softmax_attention(q, k, v, qk_dim ** -0.5)
    return o.reshape(b, s, MLA_HEADS * MLA_V)


def fnet_mixer(u):
    b, s, _ = u.shape
    uf = u.astype(jnp.float32).reshape(b, s, FNET_GROUPS, FNET_GROUP_DIM)
    y = jnp.fft.fft2(uf, axes=(1, 3), norm='ortho').real
    return y.reshape(b, s, FNET_GROUPS * FNET_GROUP_DIM).astype(u.dtype)


def diff_mixer(q_in, k_in, v_in, g_qn, g_kn, lq1, lk1, lq2, lk2, g_sub, layer_idx, cos, sin):
    b, s, _ = q_in.shape
    d = DIFF_HEAD_DIM
    q = apply_rope(rmsnorm(q_in.reshape(b, s, 2 * DIFF_HEADS, d), g_qn), cos, sin)
    k = apply_rope(rmsnorm(k_in.reshape(b, s, 2 * DIFF_HEADS, d), g_kn), cos, sin)
    q = q.reshape(b, s, DIFF_HEADS, 2, d)
    k = k.reshape(b, s, DIFF_HEADS, 2, d)
    v = v_in.reshape(b, s, DIFF_HEADS, 2 * d)
    lambda_init = 0.8 - 0.6 * math.exp(-0.3 * layer_idx)
    lam = (jnp.exp(jnp.sum(lq1.astype(jnp.float32) * lk1.astype(jnp.float32)))
           - jnp.exp(jnp.sum(lq2.astype(jnp.float32) * lk2.astype(jnp.float32)))
           + lambda_init)
    o = block_diff_attention(q[:, :, :, 0], q[:, :, :, 1], k[:, :, :, 0], k[:, :, :, 1], v, lam, d ** -0.5)
    o = rmsnorm(o, g_sub) * (1.0 - lambda_init)
    return o.reshape(b, s, DIFF_HEADS * 2 * d)


def hgrn2_chunk_scan(q, k, v, log_f):
    b, s, h, dk = q.shape
    dv = v.shape[-1]
    c = HGRN_CHUNK
    n_chunks = s // c

    def chunks(t):
        return t.reshape(b, n_chunks, c, h, t.shape[-1]).transpose(1, 0, 3, 2, 4)

    lower_tri = jnp.tril(jnp.ones((c, c), dtype=bool))[:, :, None]

    def step(state, inp):
        qc, kc, vc, lc = inp
        cum = jnp.cumsum(lc, axis=2)
        inter = jnp.einsum('bhtk,bhkv->bhtv', qc * jnp.exp(cum), state)
        rel = cum[:, :, :, None, :] - cum[:, :, None, :, :]
        decay = jnp.exp(jnp.where(lower_tri, rel, -jnp.inf))
        scores = jnp.einsum('bhtk,bhtsk,bhsk->bhts', qc, decay, kc)
        intra = jnp.einsum('bhts,bhsv->bhtv', scores, vc)
        last = cum[:, :, -1:, :]
        new_state = (jnp.exp(last[:, :, 0, :])[..., None] * state
                     + jnp.einsum('bhsk,bhsv->bhkv', kc * jnp.exp(last - cum), vc))
        return new_state, inter + intra

    init = jnp.zeros((b, h, dk, dv), jnp.float32)
    _, o = lax.scan(step, init, (chunks(q), chunks(k), chunks(v), chunks(log_f)))
    return o.transpose(1, 0, 3, 2, 4).reshape(b, s, h, dv)


def hgrn2_mixer(q_in, i_in, f_fwd_in, f_bwd_in, g_in, lb_fwd, lb_bwd, g_on):
    b, s, _ = q_in.shape
    h, dk, dv = HGRN_HEADS, HGRN_KEY_DIM, HGRN_VAL_DIM
    q = q_in.astype(jnp.float32).reshape(b, s, h, dk)
    v = i_in.astype(jnp.float32).reshape(b, s, h, dv)

    def forget(z, lb):
        lbh = lb.reshape(h, dk)
        f = lbh + (1.0 - lbh) * jax.nn.sigmoid(z.astype(jnp.float32).reshape(b, s, h, dk))
        return 1.0 - f, jnp.log(f)

    k_f, lf_f = forget(f_fwd_in, lb_fwd)
    k_b, lf_b = forget(f_bwd_in, lb_bwd)
    o_fwd = hgrn2_chunk_scan(q, k_f, v, lf_f)
    o_bwd = jnp.flip(hgrn2_chunk_scan(jnp.flip(q, 1), jnp.flip(k_b, 1), jnp.flip(v, 1), jnp.flip(lf_b, 1)), 1)
    o = rmsnorm(o_fwd + o_bwd, g_on) * jax.nn.sigmoid(g_in.astype(jnp.float32).reshape(b, s, h, dv))
    return o.reshape(b, s, h * dv).astype(q_in.dtype)


def setup_inputs(seed: int = 0) -> dict:
    key = jax.random.key(seed)
    ks = jax.random.split(key, 24)
    L = DEPTH
    qk_m = MLA_NOPE + MLA_ROPE

    def nrm(k, shape, scale):
        return jax.random.normal(k, shape, jnp.float32) * scale

    def gain(k, shape):
        return 1.0 + 0.02 * jax.random.normal(k, shape, jnp.float32)

    return {
        'x': nrm(ks[0], (BATCH, SEQ, D_MODEL), 1.0),
        'ln_mix': gain(ks[1], (L, D_MODEL)),
        'w_in': nrm(ks[2], (L, D_MODEL, IN_TOTAL), D_MODEL ** -0.5),
        'mla_g_qa': gain(ks[3], (L, MLA_Q_LORA)),
        'mla_w_uq': nrm(ks[4], (L, MLA_Q_LORA, MLA_HEADS * qk_m), MLA_Q_LORA ** -0.5),
        'mla_g_kva': gain(ks[5], (L, MLA_KV_LORA)),
        'mla_w_ukv': nrm(ks[6], (L, MLA_KV_LORA, MLA_HEADS * (MLA_NOPE + MLA_V)), MLA_KV_LORA ** -0.5),
        'mla_g_qn': gain(ks[7], (L, qk_m)),
        'mla_g_kn': gain(ks[8], (L, qk_m)),
        'diff_g_qn': gain(ks[9], (L, DIFF_HEAD_DIM)),
        'diff_g_kn': gain(ks[10], (L, DIFF_HEAD_DIM)),
        'diff_lq1': nrm(ks[11], (L, DIFF_HEAD_DIM), 0.1),
        'diff_lk1': nrm(ks[12], (L, DIFF_HEAD_DIM), 0.1),
        'diff_lq2': nrm(ks[13], (L, DIFF_HEAD_DIM), 0.1),
        'diff_lk2': nrm(ks[14], (L, DIFF_HEAD_DIM), 0.1),
        'diff_g_sub': gain(ks[15], (L, 2 * DIFF_HEAD_DIM)),
        'hgrn_lb_logits': nrm(ks[16], (2, L, HGRN_HEADS * HGRN_KEY_DIM), 0.5),
        'hgrn_g_on': gain(ks[17], (L, HGRN_VAL_DIM)),
        'w_branch': nrm(ks[18], (L, N_BRANCH, BRANCH_WIDTH, D_MODEL), BRANCH_WIDTH ** -0.5),
        'w_out': nrm(ks[19], (L, D_MODEL, D_MODEL), D_MODEL ** -0.5),
        'ln_ffn': gain(ks[20], (L, D_MODEL)),
        'w_gate_up': nrm(ks[21], (L, D_MODEL, 2 * D_FF), D_MODEL ** -0.5),
        'w_down': nrm(ks[22], (L, D_FF, D_MODEL), D_FF ** -0.5),
    }


def reference(x, ln_mix, w_in, mla_g_qa, mla_w_uq, mla_g_kva, mla_w_ukv, mla_g_qn, mla_g_kn,
              diff_g_qn, diff_g_kn, diff_lq1, diff_lk1, diff_lq2, diff_lk2, diff_g_sub,
              hgrn_lb_logits, hgrn_g_on, w_branch, w_out, ln_ffn, w_gate_up, w_down):
    seq_len = x.shape[1]
    cos_m, sin_m = rope_tables(seq_len, MLA_ROPE)
    cos_d, sin_d = rope_tables(seq_len, DIFF_HEAD_DIM)
    lb_p = jax.nn.softmax(hgrn_lb_logits.astype(jnp.float32), axis=1)
    lower_bounds = jnp.cumsum(lb_p, axis=1) - lb_p[:, :1]

    for l in range(DEPTH):
        h = rmsnorm(x, ln_mix[l])
        z = h @ w_in[l]
        (c_q, c_kv, k_rope, fnet_in, dq, dk, dv,
         hq, hi, hf_fwd, hf_bwd, hg, gate_logits) = split_cols(z, IN_WIDTHS)

        o_mla = mla_mixer(c_q, c_kv, k_rope, mla_g_qa[l], mla_w_uq[l], mla_g_kva[l], mla_w_ukv[l],
                          mla_g_qn[l], mla_g_kn[l], cos_m, sin_m)
        o_fnet = fnet_mixer(fnet_in)
        o_diff = diff_mixer(dq, dk, dv, diff_g_qn[l], diff_g_kn[l], diff_lq1[l], diff_lk1[l],
                            diff_lq2[l], diff_lk2[l], diff_g_sub[l], l, cos_d, sin_d)
        o_hgrn = hgrn2_mixer(hq, hi, hf_fwd, hf_bwd, hg, lower_bounds[0, l], lower_bounds[1, l],
                             hgrn_g_on[l])

        merged = jnp.zeros_like(x)
        for n, o_branch in enumerate((o_mla, o_fnet, o_diff, o_hgrn)):
            gate = jax.nn.sigmoid(gate_logits[..., n * D_MODEL:(n + 1) * D_MODEL].astype(jnp.float32))
            merged = merged + gate.astype(x.dtype) * (o_branch @ w_branch[l, n])
        x = x + merged @ w_out[l]

        h2 = rmsnorm(x, ln_ffn[l])
        g_part, u_part = jnp.split(h2 @ w_gate_up[l], 2, axis=-1)
        x = x + (jax.nn.silu(g_part) * u_part) @ w_down[l]
    return x
```

```cpp
#include <hip/hip_runtime.h>
#include <hip/hip_cooperative_groups.h>
#include <cstdio>
namespace cg = cooperative_groups;

#ifndef MK_ONE_LAUNCH
#define MK_ONE_LAUNCH 1
#endif

#define DI __device__ __forceinline__
typedef unsigned short u16;
typedef __bf16 bf2_t __attribute__((ext_vector_type(2)));
typedef float f2_t __attribute__((ext_vector_type(2)));
using bf16x8 = __attribute__((ext_vector_type(8))) short;
using s16x4 = __attribute__((ext_vector_type(4))) short;
using f32x16 = __attribute__((ext_vector_type(16))) float;
#define MFMA(a, b, c) __builtin_amdgcn_mfma_f32_32x32x16_bf16((a), (b), (c), 0, 0, 0)

constexpr int T = 32768, SEQ = 8192, ZW = 2336, INW = 6944, DFF = 2816;
constexpr float EPS = 1e-6f;
constexpr float LOG2E = 1.4426950408889634f;

constexpr size_t O_WZ = 0;
constexpr size_t O_WF = O_WZ + 2432ull * 1024 * 2;
constexpr size_t O_WG = O_WF + 512ull * 1024 * 2;
constexpr size_t O_WUQ = O_WG + 4096ull * 1024 * 2;
constexpr size_t O_WKN = O_WUQ + 384ull * 384 * 2;
constexpr size_t O_WV = O_WKN + 256ull * 128 * 2;
constexpr size_t O_WB0 = O_WV + 256ull * 128 * 2;
constexpr size_t O_WB1 = O_WB0 + 1024ull * 256 * 2;
constexpr size_t O_WB2 = O_WB1 + 1024ull * 512 * 2;
constexpr size_t O_WB3 = O_WB2 + 1024ull * 256 * 2;
constexpr size_t O_WO = O_WB3 + 1024ull * 256 * 2;
constexpr size_t O_WGU = O_WO + 1024ull * 1024 * 2;
constexpr size_t O_WD = O_WGU + 5632ull * 1024 * 2;
constexpr size_t O_RC = O_WD + 1024ull * 2816 * 2;
constexpr size_t O_RS = O_RC + 8192ull * 16 * 4;
constexpr size_t O_E1 = O_RS + 8192ull * 16 * 4;
constexpr size_t O_E2 = O_E1 + 256ull * 128 * 2;
constexpr size_t O_H = O_E2 + 128ull * 128 * 2;
constexpr size_t O_OF = O_H + (size_t)T * 1024 * 2;
constexpr size_t O_Z = O_OF + (size_t)T * 512 * 2;
constexpr size_t O_UT = O_Z + (size_t)T * ZW * 2;
constexpr size_t O_QM = O_UT;
constexpr size_t O_GT = O_UT + (size_t)T * 384 * 2;
constexpr size_t O_OH = O_GT;
constexpr size_t O_VDT = O_GT + (size_t)T * 512 * 2;
constexpr size_t O_QRAW = O_VDT + (size_t)T * 256 * 2;
constexpr size_t O_OM = O_QRAW;
constexpr size_t O_KN = O_QRAW + (size_t)T * 384 * 2;
constexpr size_t O_OD = O_KN;
constexpr size_t O_VMT = O_KN + (size_t)T * 256 * 2;
constexpr size_t O_KM = O_VMT + (size_t)T * 256 * 2;
constexpr size_t O_QD = O_KM + (size_t)T * 384 * 2;
constexpr size_t O_KD = O_QD + (size_t)T * 256 * 2;
constexpr size_t O_ST = O_KD + (size_t)T * 256 * 2;
constexpr size_t O_DEC = O_ST + 4096ull * 4096 * 2;
constexpr size_t O_END = O_DEC + 4096ull * 64 * 4;
constexpr size_t O_MG = O_Z;
constexpr size_t O_ACT = O_Z;

constexpr int SMEM_BYTES = 73728 + 1024;

struct Params {
  const float* in[23];
  float* out;
  char* ws;
};

DI int tidx() { int t = threadIdx.x; asm volatile("" : "+v"(t)); return t; }
DI int bidx() { int t = blockIdx.x; asm volatile("" : "+s"(t)); return t; }
DI float bf2f(u16 v) { return __uint_as_float(((unsigned)v) << 16); }
DI float bflo(unsigned v) { return __uint_as_float(v << 16); }
DI float bfhi(unsigned v) { return __uint_as_float(v & 0xffff0000u); }
DI unsigned pack2(float a, float b) {
  f2_t v = {a, b};
  return __builtin_bit_cast(unsigned, __builtin_convertvector(v, bf2_t));
}
DI u16 f2bf(float a) { return (u16)(pack2(a, 0.f) & 0xffffu); }
DI float sigmoid_fast(float x) { return __builtin_amdgcn_rcpf(1.f + __expf(-x)); }
DI int crow(int r, int hh) { return (r & 3) + 8 * (r >> 2) + 4 * hh; }
DI void unpack8(const uint4& v, float* x) {
  x[0] = bflo(v.x); x[1] = bfhi(v.x); x[2] = bflo(v.y); x[3] = bfhi(v.y);
  x[4] = bflo(v.z); x[5] = bfhi(v.z); x[6] = bflo(v.w); x[7] = bfhi(v.w);
}
DI uint4 pack8(const float* x) {
  uint4 o; o.x = pack2(x[0], x[1]); o.y = pack2(x[2], x[3]); o.z = pack2(x[4], x[5]); o.w = pack2(x[6], x[7]);
  return o;
}

template <int WN>
DI void gemm_ml(const u16* __restrict__ A, long lda, const u16* __restrict__ B, long ldb, int K,
                f32x16 (&acc)[2][WN], u16* sm) {
  const int tid = tidx(), lane = tid & 63, wave = tid >> 6, l31 = lane & 31, hh = lane >> 5;
  const int wm = wave >> 1, wn = wave & 1;
  const int chunk = tid & 7, row0 = tid >> 3;
  u16* sa = sm;
  u16* sb = sm + 2 * 128 * 72;
  uint4 ra[4], rb[2 * WN];
  const u16* ga = A + (long)row0 * lda + chunk * 8;
  const u16* gb = B + (long)row0 * ldb + chunk * 8;
  const int nk = K >> 6;
#pragma unroll
  for (int i = 0; i < 4; ++i) ra[i] = *(const uint4*)(ga + (long)(32 * i) * lda);
#pragma unroll
  for (int i = 0; i < 2 * WN; ++i) rb[i] = *(const uint4*)(gb + (long)(32 * i) * ldb);
#pragma unroll
  for (int i = 0; i < 4; ++i) *(uint4*)(sa + (row0 + 32 * i) * 72 + chunk * 8) = ra[i];
#pragma unroll
  for (int i = 0; i < 2 * WN; ++i) *(uint4*)(sb + (row0 + 32 * i) * 72 + chunk * 8) = rb[i];
  __syncthreads();
  for (int kt = 0; kt < nk; ++kt) {
    const int buf = kt & 1;
    if (kt + 1 < nk) {
      const int ko = (kt + 1) * 64;
#pragma unroll
      for (int i = 0; i < 4; ++i) ra[i] = *(const uint4*)(ga + (long)(32 * i) * lda + ko);
#pragma unroll
      for (int i = 0; i < 2 * WN; ++i) rb[i] = *(const uint4*)(gb + (long)(32 * i) * ldb + ko);
    }
    const u16* pa = sa + buf * 128 * 72 + (wm * 64 + l31) * 72 + hh * 8;
    const u16* pb = sb + buf * 128 * 72 + (wn * 32 * WN + l31) * 72 + hh * 8;
#pragma unroll
    for (int ks = 0; ks < 4; ++ks) {
      bf16x8 af[2], bfr[WN];
#pragma unroll
      for (int mt = 0; mt < 2; ++mt) af[mt] = *(const bf16x8*)(pa + mt * 32 * 72 + ks * 16);
#pragma unroll
      for (int nt = 0; nt < WN; ++nt) bfr[nt] = *(const bf16x8*)(pb + nt * 32 * 72 + ks * 16);
#pragma unroll
      for (int mt = 0; mt < 2; ++mt)
#pragma unroll
        for (int nt = 0; nt < WN; ++nt) acc[mt][nt] = MFMA(af[mt], bfr[nt], acc[mt][nt]);
    }
    if (kt + 1 < nk) {
      const int nb = buf ^ 1;
#pragma unroll
      for (int i = 0; i < 4; ++i) *(uint4*)(sa + nb * 128 * 72 + (row0 + 32 * i) * 72 + chunk * 8) = ra[i];
#pragma unroll
      for (int i = 0; i < 2 * WN; ++i) *(uint4*)(sb + nb * 128 * 72 + (row0 + 32 * i) * 72 + chunk * 8) = rb[i];
    }
    __syncthreads();
  }
}

template <int WN>
DI void zero_acc(f32x16 (&acc)[2][WN]) {
#pragma unroll
  for (int mt = 0; mt < 2; ++mt)
#pragma unroll
    for (int nt = 0; nt < WN; ++nt)
#pragma unroll
      for (int r = 0; r < 16; ++r) acc[mt][nt][r] = 0.f;
}

template <int WN, class F>
DI void epi(f32x16 (&acc)[2][WN], F f) {
  const int lane = tidx() & 63, wave = tidx() >> 6, l31 = lane & 31, hh = lane >> 5;
  const int wm = wave >> 1, wn = wave & 1;
#pragma unroll
  for (int mt = 0; mt < 2; ++mt)
#pragma unroll
    for (int nt = 0; nt < WN; ++nt)
#pragma unroll
      for (int r = 0; r < 16; ++r)
        f(wm * 64 + mt * 32 + crow(r, hh), wn * 32 * WN + nt * 32 + l31, acc[mt][nt][r]);
}

DI void block_rstd(const u16* base, long ld, int ncols, float* out) {
  const int tid = tidx(), row = tid >> 1, half = tid & 1;
  const int n2 = ncols >> 1;
  const u16* p = base + (long)row * ld + half * n2;
  float ss = 0.f;
  for (int i = 0; i < n2; i += 8) {
    uint4 v = *(const uint4*)(p + i);
    float x[8]; unpack8(v, x);
#pragma unroll
    for (int j = 0; j < 8; ++j) ss += x[j] * x[j];
  }
  ss += __shfl_xor(ss, 1);
  if (half == 0) out[row] = rsqrtf(ss / (float)ncols + EPS);
}

template <class CM, class SC>
DI void convT(u16* dst, int N, int K, const float* __restrict__ src, long ld, CM cm, SC sc) {
  const long total = (long)N * K / 8;
  const int kbn = K / 32;
  for (long i = bidx() * 256L + tidx(); i < total; i += gridDim.x * 256L) {
    const int kq = (int)(i & 3), nl = (int)((i >> 2) & 15);
    const long rest = i >> 6;
    const int kb = (int)(rest % kbn), nb = (int)(rest / kbn);
    const int n = nb * 16 + nl, k0 = kb * 32 + kq * 8;
    const int c = cm(n);
    float v[8];
#pragma unroll
    for (int j = 0; j < 8; ++j) v[j] = (c >= 0) ? src[(long)(k0 + j) * ld + c] * sc(k0 + j) : 0.f;
    *(uint4*)(dst + (long)n * K + k0) = pack8(v);
  }
}

DI void ph_wprep(const Params& p, int l) {
  char* ws = p.ws;
  auto one = [](int) { return 1.f; };
  const float* w_in = p.in[2] + (size_t)l * 1024 * INW;
  convT((u16*)(ws + O_WZ), 2432, 1024, w_in, INW,
        [](int n) { return n < 544 ? n : (n < 1056 ? n + 256 : (n < ZW ? n + 512 : -1)); }, one);
  convT((u16*)(ws + O_WF), 512, 1024, w_in, INW, [](int n) { return n < 256 ? 544 + n : 1312 + (n - 256); }, one);
  convT((u16*)(ws + O_WG), 4096, 1024, w_in, INW, [](int n) { return 2848 + n; }, one);
  {
    const float* g = p.in[3] + l * 384;
    convT((u16*)(ws + O_WUQ), 384, 384, p.in[4] + (size_t)l * 384 * 384, 384, [](int n) { return n; },
          [g](int k) { return g[k]; });
  }
  {
    const float* g = p.in[5] + l * 128;
    const float* w = p.in[6] + (size_t)l * 128 * 512;
    convT((u16*)(ws + O_WKN), 256, 128, w, 512, [](int n) { return (n >> 6) * 128 + (n & 63); }, [g](int k) { return g[k]; });
    convT((u16*)(ws + O_WV), 256, 128, w, 512, [](int n) { return (n >> 6) * 128 + 64 + (n & 63); }, [g](int k) { return g[k]; });
  }
  const float* wb = p.in[18] + (size_t)l * 4 * 256 * 1024;
  convT((u16*)(ws + O_WB0), 1024, 256, wb, 1024, [](int n) { return n; }, one);
  convT((u16*)(ws + O_WB2), 1024, 256, wb + 2 * 256 * 1024, 1024, [](int n) { return n; }, one);
  convT((u16*)(ws + O_WB3), 1024, 256, wb + 3 * 256 * 1024, 1024, [](int n) { return n; }, one);
  convT((u16*)(ws + O_WO), 1024, 1024, p.in[19] + (size_t)l * 1024 * 1024, 1024, [](int n) { return n; }, one);
  convT((u16*)(ws + O_WGU), 5632, 1024, p.in[21] + (size_t)l * 1024 * 5632, 5632,
        [](int R) {
          const int tile = R >> 7, w = R & 127;
          const int col = tile * 64 + (w >> 6) * 32 + (w & 31);
          return ((w >> 5) & 1) ? DFF + col : col;
        },
        one);
  convT((u16*)(ws + O_WD), 1024, 2816, p.in[22] + (size_t)l * DFF * 1024, 1024, [](int n) { return n; }, one);
  {
    u16* dst = (u16*)(ws + O_WB1);
    const float* w1 = wb + 1 * 256 * 1024;
    for (int i = bidx() * 256 + tidx(); i < 1024 * 512; i += gridDim.x * 256) {
      const int j = i & 1023, kk = i >> 10;
      const int sel = kk >> 8, g = (kk >> 6) & 3, cc = kk & 63;
      float a = 0.f;
      for (int c2 = 0; c2 < 64; ++c2) {
        const float fr = (float)((cc * c2) & 63) * (1.f / 64.f);
        const float tr = sel ? -__builtin_amdgcn_sinf(fr) : __builtin_amdgcn_cosf(fr);
        a += tr * w1[(g * 64 + c2) * 1024 + j];
      }
      dst[j * 512 + kk] = f2bf(a * 0.125f);
    }
  }
  if (l == 0) {
    float* rc = (float*)(ws + O_RC);
    float* rs = (float*)(ws + O_RS);
    for (int i = bidx() * 256 + tidx(); i < 8192 * 16; i += gridDim.x * 256) {
      const int pos = i >> 4, fi = i & 15;
      const float invf = 1.0f / exp2f((float)fi * 0.8304820237218407f);
      const float ang = (float)pos * invf;
      double rv = (double)ang * 0.15915494309189535;
      rv -= floor(rv);
      const float fr = (float)rv;
      rc[i] = __builtin_amdgcn_cosf(fr);
      rs[i] = __builtin_amdgcn_sinf(fr);
    }
    u16* e1 = (u16*)(ws + O_E1);
    for (int i = bidx() * 256 + tidx(); i < 256 * 128; i += gridDim.x * 256) {
      const int R = i >> 7, s1 = i & 127;
      const int p1 = (R >> 7) * 64 + ((R >> 6) & 1) * 32 + (R & 31), ri = (R >> 5) & 1;
      const float fr = (float)((p1 * s1) & 127) * (1.f / 128.f);
      const float v = ri ? -__builtin_amdgcn_sinf(fr) : __builtin_amdgcn_cosf(fr);
      e1[i] = f2bf(v * 0.08838834764831845f);
    }
    u16* e2 = (u16*)(ws + O_E2);
    for (int i = bidx() * 256 + tidx(); i < 128 * 128; i += gridDim.x * 256) {
      const int R = i >> 7, kk = i & 127;
      const int sel = R >> 6, p2 = R & 63, s2 = kk >> 1, ri = kk & 1;
      const float fr = (float)((p2 * s2) & 63) * (1.f / 64.f);
      const float c = __builtin_amdgcn_cosf(fr), s = __builtin_amdgcn_sinf(fr);
      const float v = sel == 0 ? (ri == 0 ? c : s) : (ri == 0 ? s : -c);
      e2[i] = f2bf(v * 0.125f);
    }
  }
}

DI void ph_rmsnorm(const float* __restrict__ x, const float* __restrict__ g, u16* __restrict__ H) {
  const int lane = tidx() & 63, wave = tidx() >> 6;
  for (int row = bidx() * 4 + wave; row < T; row += gridDim.x * 4) {
    const float4* xr = (const float4*)(x + (size_t)row * 1024);
    float4 v[4];
    float ss = 0.f;
#pragma unroll
    for (int i = 0; i < 4; ++i) {
      v[i] = xr[lane + 64 * i];
      ss += v[i].x * v[i].x + v[i].y * v[i].y + v[i].z * v[i].z + v[i].w * v[i].w;
    }
#pragma unroll
    for (int o = 32; o >= 1; o >>= 1) ss += __shfl_xor(ss, o);
    const float r = rsqrtf(ss * (1.f / 1024.f) + EPS);
#pragma unroll
    for (int i = 0; i < 4; ++i) {
      const float4 gg = ((const float4*)g)[lane + 64 * i];
      uint2 o;
      o.x = pack2(v[i].x * r * gg.x, v[i].y * r * gg.y);
      o.y = pack2(v[i].z * r * gg.z, v[i].w * r * gg.w);
      *(uint2*)(H + (size_t)row * 1024 + (lane + 64 * i) * 4) = o;
    }
  }
}

DI void ph_inproj(const Params& p, u16* sm) {
  char* ws = p.ws;
  const u16* H = (const u16*)(ws + O_H);
  u16* Z = (u16*)(ws + O_Z);
  u16* UT = (u16*)(ws + O_UT);
  u16* VDT = (u16*)(ws + O_VDT);
  constexpr int NA = 256 * 19, NB = 4 * 256;
  for (int it = bidx(); it < NA + NB; it += gridDim.x) {
    f32x16 acc[2][2];
    zero_acc<2>(acc);
    if (it < NA) {
      const int tn = it % 19, tm = it / 19;
      gemm_ml<2>(H + (size_t)tm * 128 * 1024, 1024, (const u16*)(ws + O_WZ) + (size_t)tn * 128 * 1024, 1024, 1024, acc, sm);
      epi<2>(acc, [&](int m, int n, float v) {
        const int col = tn * 128 + n;
        if (col < ZW) Z[(size_t)(tm * 128 + m) * ZW + col] = f2bf(v);
      });
    } else {
      const int j = it - NA;
      const int tmf = j & 3, nt = j >> 2;
      const u16* A = (const u16*)(ws + O_WF) + (size_t)tmf * 128 * 1024;
      if (tmf < 2) {
        const int b = nt >> 6, s2 = nt & 63;
        gemm_ml<2>(A, 1024, H + ((size_t)b * 8192 + s2) * 1024, 64 * 1024, 1024, acc, sm);
        epi<2>(acc, [&](int m, int n, float v) {
          const int c = tmf * 128 + m;
          UT[(((size_t)b * 256 + c) * 64 + s2) * 128 + n] = f2bf(v);
        });
      } else {
        gemm_ml<2>(A, 1024, H + (size_t)nt * 128 * 1024, 1024, 1024, acc, sm);
        epi<2>(acc, [&](int m, int n, float v) {
          const int feat = (tmf - 2) * 128 + m;
          VDT[(size_t)feat * T + nt * 128 + n] = f2bf(v);
        });
      }
    }
  }
}

DI float hgrn_lb(const Params& p, int l, int dir, int ch) {
  if (l == 0) return 0.f;
  const float* lg = p.in[16] + dir * 2 * 256;
  const float x0 = lg[ch], x1 = lg[256 + ch];
  return 1.f / (1.f + expf(x0 - x1));
}

DI void hgrn_gates(const u16* zcol  , float lb, int dir, int w, int k, float* tot  ,
                   float (&cum)[16], float (&kk)[16], float& total) {
  float lf[16];
#pragma unroll
  for (int j = 0; j < 16; ++j) {
    const float z = bf2f(zcol[(size_t)(w * 16 + j) * ZW]);
    const float sg = 1.f / (1.f + expf(-z));
    const float f = lb + (1.f - lb) * sg;
    lf[j] = logf(f);
    kk[j] = 1.f - f;
  }
  float pre[16];
  float run = 0.f;
#pragma unroll
  for (int j = 0; j < 16; ++j) { run += lf[j]; pre[j] = run; }
  tot[w * 64 + k] = run;
  __syncthreads();
  const float t0 = tot[k], t1 = tot[64 + k], t2 = tot[128 + k], t3 = tot[192 + k];
  total = t0 + t1 + t2 + t3;
  float before = 0.f;
  if (w > 0) before += t0;
  if (w > 1) before += t1;
  if (w > 2) before += t2;
  const float after = total - before - run;
#pragma unroll
  for (int j = 0; j < 16; ++j) cum[j] = dir ? (after + run - pre[j] + lf[j]) : (before + pre[j]);
}

DI void hgrn_h1(const Params& p, int l, int item, u16* sm) {
  char* ws = p.ws;
  const u16* Z = (const u16*)(ws + O_Z);
  u16* ST = (u16*)(ws + O_ST);
  float* DEC = (float*)(ws + O_DEC);
  const int chunk = item & 127, dir = (item >> 7) & 1, h = (item >> 8) & 3, b = item >> 10;
  const int tid = tidx(), k = tid & 63, w = tid >> 6, lane = tid & 63, l31 = lane & 31, hh = lane >> 5;
  const size_t tok0 = (size_t)b * 8192 + chunk * 64;
  u16* KT = sm;
  u16* VT = sm + 64 * 72;
  float* tot = (float*)(sm + 2 * 64 * 72);
  float cum[16], kk[16], total;
  hgrn_gates(Z + tok0 * ZW + (dir ? 1824 : 1568) + h * 64 + k, hgrn_lb(p, l, dir, h * 64 + k), dir, w, k, tot, cum, kk, total);
  float kv[16], vv[16];
#pragma unroll
  for (int j = 0; j < 16; ++j) {
    kv[j] = kk[j] * expf(total - cum[j]);
    vv[j] = bf2f(Z[(tok0 + w * 16 + j) * ZW + 1312 + h * 64 + k]);
  }
  *(uint4*)(KT + k * 72 + w * 16) = pack8(kv);
  *(uint4*)(KT + k * 72 + w * 16 + 8) = pack8(kv + 8);
  *(uint4*)(VT + k * 72 + w * 16) = pack8(vv);
  *(uint4*)(VT + k * 72 + w * 16 + 8) = pack8(vv + 8);
  if (w == 0) DEC[(size_t)item * 64 + k] = expf(total);
  __syncthreads();
  const int mt = w >> 1, nt = w & 1;
  f32x16 acc;
#pragma unroll
  for (int r = 0; r < 16; ++r) acc[r] = 0.f;
#pragma unroll
  for (int ks = 0; ks < 4; ++ks) {
    const bf16x8 a = *(const bf16x8*)(VT + (mt * 32 + l31) * 72 + ks * 16 + hh * 8);
    const bf16x8 bq = *(const bf16x8*)(KT + (nt * 32 + l31) * 72 + ks * 16 + hh * 8);
    acc = MFMA(a, bq, acc);
  }
#pragma unroll
  for (int r = 0; r < 16; ++r) ST[(size_t)item * 4096 + (mt * 32 + crow(r, hh)) * 64 + nt * 32 + l31] = f2bf(acc[r]);
  __syncthreads();
}

DI void hgrn_h2(const Params& p) {
  char* ws = p.ws;
  u16* ST = (u16*)(ws + O_ST);
  const float* DEC = (const float*)(ws + O_DEC);
  for (int pi = bidx() * 256 + tidx(); pi < 32 * 2048; pi += gridDim.x * 256) {
    const int chain = pi >> 11, e2 = pi & 2047, dir = chain & 1;
    const int k = (2 * e2) & 63;
    float s0 = 0.f, s1 = 0.f;
#pragma unroll 8
    for (int c = 0; c < 128; ++c) {
      const int chunk = dir ? 127 - c : c;
      const size_t item = (size_t)chain * 128 + chunk;
      unsigned* ptr = (unsigned*)(ST + item * 4096 + 2 * e2);
      const unsigned u = *ptr;
      const float2 d = *(const float2*)(DEC + item * 64 + k);
      *ptr = pack2(s0, s1);
      s0 = d.x * s0 + bflo(u);
      s1 = d.y * s1 + bfhi(u);
    }
  }
}

DI void hgrn_h3(const Params& p, int l, int item, u16* sm) {
  char* ws = p.ws;
  const u16* Z = (const u16*)(ws + O_Z);
  const u16* ST = (const u16*)(ws + O_ST);
  u16* OH = (u16*)(ws + O_OH);
  const int chunk = item & 127, h = (item >> 7) & 3, b = item >> 9;
  const int tid = tidx(), k = tid & 63, w = tid >> 6, lane = tid & 63, l31 = lane & 31, hh = lane >> 5;
  const size_t tok0 = (size_t)b * 8192 + chunk * 64;
  u16* Q1 = sm;
  u16* Q2 = sm + 64 * 72;
  u16* KT = sm + 2 * 64 * 72;
  u16* VT = sm + 3 * 64 * 72;
  float* tot = (float*)(sm + 4 * 64 * 72);
  float* ssum = tot + 256;
  const int vt = w >> 1, tt = w & 1;
  {
    float vv[16];
#pragma unroll
    for (int j = 0; j < 16; ++j) vv[j] = bf2f(Z[(tok0 + w * 16 + j) * ZW + 1312 + h * 64 + k]);
    *(uint4*)(VT + k * 72 + w * 16) = pack8(vv);
    *(uint4*)(VT + k * 72 + w * 16 + 8) = pack8(vv + 8);
  }
  f32x16 O;
#pragma unroll
  for (int r = 0; r < 16; ++r) O[r] = 0.f;
  for (int dir = 0; dir < 2; ++dir) {
    float cum[16], kk[16], total;
    hgrn_gates(Z + tok0 * ZW + (dir ? 1824 : 1568) + h * 64 + k, hgrn_lb(p, l, dir, h * 64 + k), dir, w, k, tot, cum, kk, total);
    const float ref = 0.5f * total;
#pragma unroll
    for (int j = 0; j < 16; ++j) {
      const int t = w * 16 + j;
      const float q = bf2f(Z[(tok0 + t) * ZW + 1056 + h * 64 + k]);
      Q1[t * 72 + k] = f2bf(q * expf(cum[j] - ref));
      Q2[t * 72 + k] = f2bf(q * expf(cum[j]));
      KT[t * 72 + k] = f2bf(kk[j] * expf(ref - cum[j]));
    }
    __syncthreads();
    const size_t sti = ((size_t)((b * 4 + h) * 2 + dir) * 128 + chunk) * 4096;
#pragma unroll
    for (int sb = 0; sb < 2; ++sb) {
      f32x16 sc;
#pragma unroll
      for (int r = 0; r < 16; ++r) sc[r] = 0.f;
#pragma unroll
      for (int ks = 0; ks < 4; ++ks) {
        const bf16x8 a = *(const bf16x8*)(KT + (sb * 32 + l31) * 72 + ks * 16 + hh * 8);
        const bf16x8 bq = *(const bf16x8*)(Q1 + (tt * 32 + l31) * 72 + ks * 16 + hh * 8);
        sc = MFMA(a, bq, sc);
      }
      const int tcol = tt * 32 + l31;
      float pm[16];
#pragma unroll
      for (int r = 0; r < 16; ++r) {
        const int srow = sb * 32 + crow(r, hh);
        const bool keep = dir ? (srow >= tcol) : (srow <= tcol);
        pm[r] = keep ? sc[r] : 0.f;
      }
#pragma unroll
      for (int ts = 0; ts < 2; ++ts) {
        const uint4 pk = pack8(pm + 8 * ts);
        const bf16x8 pf = __builtin_bit_cast(bf16x8, pk);
        const u16* vp = VT + (vt * 32 + l31) * 72 + sb * 32 + ts * 16 + hh * 4;
        const s16x4 lo = *(const s16x4*)vp;
        const s16x4 hi = *(const s16x4*)(vp + 8);
        const bf16x8 vf = __builtin_shufflevector(lo, hi, 0, 1, 2, 3, 4, 5, 6, 7);
        O = MFMA(vf, pf, O);
      }
    }
#pragma unroll
    for (int ks = 0; ks < 4; ++ks) {
      const bf16x8 a = *(const bf16x8*)(ST + sti + (vt * 32 + l31) * 64 + ks * 16 + hh * 8);
      const bf16x8 bq = *(const bf16x8*)(Q2 + (tt * 32 + l31) * 72 + ks * 16 + hh * 8);
      O = MFMA(a, bq, O);
    }
    __syncthreads();
  }
  float ss = 0.f;
#pragma unroll
  for (int r = 0; r < 16; ++r) ss += O[r] * O[r];
  ss += __shfl_xor(ss, 32);
  if (hh == 0) ssum[vt * 64 + tt * 32 + l31] = ss;
  __syncthreads();
  const float rr = rsqrtf((ssum[tt * 32 + l31] + ssum[64 + tt * 32 + l31]) * (1.f / 64.f) + EPS);
  const size_t tok = tok0 + tt * 32 + l31;
  const float* gon = p.in[17] + l * 64;
#pragma unroll
  for (int i = 0; i < 4; ++i) {
    const int v0 = vt * 32 + 8 * i + 4 * hh;
    const uint2 hg = *(const uint2*)(Z + tok * ZW + 2080 + h * 64 + v0);
    const float g0 = 1.f / (1.f + expf(-bflo(hg.x))), g1 = 1.f / (1.f + expf(-bfhi(hg.x)));
    const float g2 = 1.f / (1.f + expf(-bflo(hg.y))), g3 = 1.f / (1.f + expf(-bfhi(hg.y)));
    uint2 o;
    o.x = pack2(O[4 * i + 0] * rr * gon[v0 + 0] * g0, O[4 * i + 1] * rr * gon[v0 + 1] * g1);
    o.y = pack2(O[4 * i + 2] * rr * gon[v0 + 2] * g2, O[4 * i + 3] * rr * gon[v0 + 3] * g3);
    *(uint2*)(OH + tok * 256 + h * 64 + v0) = o;
  }
  __syncthreads();
}

DI void prep_diff(const Params& p, int l, int blk) {
  char* ws = p.ws;
  const u16* Z = (const u16*)(ws + O_Z);
  const float* rc = (const float*)(ws + O_RC);
  const float* rs = (const float*)(ws + O_RS);
  for (int g = 0; g < 4; ++g) {
    const int isk = g >> 1;
    const int idx = tidx() + 256 * (g & 1);
    const int tl = idx >> 3, j = idx & 7;
    const int tok = blk * 64 + tl, b = tok >> 13, s = tok & 8191;
    const u16* src = Z + (size_t)tok * ZW + (isk ? 800 : 544) + j * 32;
    const float* gain = p.in[isk ? 10 : 9] + l * 32;
    float x[32];
#pragma unroll
    for (int i = 0; i < 4; ++i) unpack8(*(const uint4*)(src + 8 * i), x + 8 * i);
    float ss = 0.f;
#pragma unroll
    for (int i = 0; i < 32; ++i) ss += x[i] * x[i];
    const float r = rsqrtf(ss * (1.f / 32.f) + EPS);
#pragma unroll
    for (int i = 0; i < 32; ++i) x[i] = x[i] * r * gain[i];
    const float sc = isk ? 1.f : 0.17677669529663687f * LOG2E;
    float y[32];
#pragma unroll
    for (int i = 0; i < 16; ++i) {
      const float c = rc[s * 16 + i], sn = rs[s * 16 + i];
      y[i] = (x[i] * c - x[i + 16] * sn) * sc;
      y[i + 16] = (x[i] * sn + x[i + 16] * c) * sc;
    }
    const int hd = j >> 1, mp = j & 1;
    u16* dst = (u16*)(ws + (isk ? O_KD : O_QD)) + ((((size_t)b * 4 + hd) * 2 + mp) * 8192 + s) * 32;
#pragma unroll
    for (int i = 0; i < 4; ++i) *(uint4*)(dst + 8 * i) = pack8(y + 8 * i);
  }
}

DI void prep_mla(const Params& p, int l, int blk) {
  char* ws = p.ws;
  const u16* Z = (const u16*)(ws + O_Z);
  const float* rc = (const float*)(ws + O_RC);
  const float* rs = (const float*)(ws + O_RS);
  const int tl = tidx() >> 2, hd = tidx() & 3;
  const int tok = blk * 64 + tl, b = tok >> 13, s = tok & 8191;
  for (int isk = 0; isk < 2; ++isk) {
    float x[96];
    if (!isk) {
      const u16* src = (const u16*)(ws + O_QRAW) + (size_t)tok * 384 + hd * 96;
#pragma unroll
      for (int i = 0; i < 12; ++i) unpack8(*(const uint4*)(src + 8 * i), x + 8 * i);
    } else {
      const u16* src = (const u16*)(ws + O_KN) + (size_t)tok * 256 + hd * 64;
#pragma unroll
      for (int i = 0; i < 8; ++i) unpack8(*(const uint4*)(src + 8 * i), x + 8 * i);
      const u16* src2 = Z + (size_t)tok * ZW + 512;
#pragma unroll
      for (int i = 0; i < 4; ++i) unpack8(*(const uint4*)(src2 + 8 * i), x + 64 + 8 * i);
    }
    const float* gain = p.in[isk ? 8 : 7] + l * 96;
    float ss = 0.f;
#pragma unroll
    for (int i = 0; i < 96; ++i) ss += x[i] * x[i];
    const float r = rsqrtf(ss * (1.f / 96.f) + EPS);
#pragma unroll
    for (int i = 0; i < 96; ++i) x[i] = x[i] * r * gain[i];
    const float sc = isk ? 1.f : 0.10206207261596575f * LOG2E;
#pragma unroll
    for (int i = 0; i < 64; ++i) x[i] *= sc;
#pragma unroll
    for (int i = 0; i < 16; ++i) {
      const float c = rc[s * 16 + i], sn = rs[s * 16 + i];
      const float a = x[64 + i], bb = x[80 + i];
      x[64 + i] = (a * c - bb * sn) * sc;
      x[80 + i] = (a * sn + bb * c) * sc;
    }
    u16* dst = (u16*)(ws + (isk ? O_KM : O_QM)) + (((size_t)b * 4 + hd) * 8192 + s) * 96;
#pragma unroll
    for (int i = 0; i < 12; ++i) *(uint4*)(dst + 8 * i) = pack8(x + 8 * i);
  }
}

#define SEG_LOOP(it, base, n) \
  _Pragma("unroll 1") for (int it = (int)((bidx() + gridDim.x - ((base) % gridDim.x)) % gridDim.x); it < (n); it += gridDim.x)

DI void ph_c(const Params& p, int l, u16* sm) {
  char* ws = p.ws;
  const u16* Z = (const u16*)(ws + O_Z);
  float* rstd = (float*)((char*)sm + 73728);
  SEG_LOOP(it, 0, 768) {
    const int tn = it % 3, tm = it / 3;
    f32x16 acc[2][2]; zero_acc<2>(acc);
    const u16* A = Z + (size_t)tm * 128 * ZW;
    block_rstd(A, ZW, 384, rstd);
    gemm_ml<2>(A, ZW, (const u16*)(ws + O_WUQ) + (size_t)tn * 128 * 384, 384, 384, acc, sm);
    u16* dst = (u16*)(ws + O_QRAW);
    epi<2>(acc, [&](int m, int n, float v) { dst[(size_t)(tm * 128 + m) * 384 + tn * 128 + n] = f2bf(v * rstd[m]); });
    __syncthreads();
  }
  SEG_LOOP(it, 768, 512) {
    const int tn = it & 1, tm = it >> 1;
    f32x16 acc[2][2]; zero_acc<2>(acc);
    const u16* A = Z + (size_t)tm * 128 * ZW + 384;
    block_rstd(A, ZW, 128, rstd);
    gemm_ml<2>(A, ZW, (const u16*)(ws + O_WKN) + (size_t)tn * 128 * 128, 128, 128, acc, sm);
    u16* dst = (u16*)(ws + O_KN);
    epi<2>(acc, [&](int m, int n, float v) { dst[(size_t)(tm * 128 + m) * 256 + tn * 128 + n] = f2bf(v * rstd[m]); });
    __syncthreads();
  }
  SEG_LOOP(it, 1280, 512) {
    const int tmf = it & 1, nt = it >> 1;
    f32x16 acc[2][2]; zero_acc<2>(acc);
    const u16* B = Z + (size_t)nt * 128 * ZW + 384;
    block_rstd(B, ZW, 128, rstd);
    gemm_ml<2>((const u16*)(ws + O_WV) + (size_t)tmf * 128 * 128, 128, B, ZW, 128, acc, sm);
    u16* dst = (u16*)(ws + O_VMT);
    epi<2>(acc, [&](int m, int n, float v) { dst[(size_t)(tmf * 128 + m) * T + nt * 128 + n] = f2bf(v * rstd[n]); });
    __syncthreads();
  }
  SEG_LOOP(it, 1792, 1024) {
    const int tmE = it & 1, tn = it >> 1;
    f32x16 acc[2][2]; zero_acc<2>(acc);
    gemm_ml<2>((const u16*)(ws + O_E1) + (size_t)tmE * 128 * 128, 128, (const u16*)(ws + O_UT) + (size_t)tn * 128 * 128, 128, 128, acc, sm);
    u16* GT = (u16*)(ws + O_GT);
    const int lane = tidx() & 63, wave = tidx() >> 6, l31 = lane & 31, hh = lane >> 5, wm = wave >> 1, wn = wave & 1;
#pragma unroll
    for (int nt = 0; nt < 2; ++nt)
#pragma unroll
      for (int r = 0; r < 16; ++r) {
        const float re = acc[0][nt][r], im = acc[1][nt][r];
        const int p1 = tmE * 64 + wm * 32 + crow(r, hh);
        const int n = tn * 128 + wn * 64 + nt * 32 + l31;
        const int b = n >> 14, c = (n >> 6) & 255, s2 = n & 63;
        const float fr = (float)(s2 * p1) * (1.f / 8192.f);
        const float cs = __builtin_amdgcn_cosf(fr), sn = __builtin_amdgcn_sinf(fr);
        const float re2 = re * cs + im * sn, im2 = im * cs - re * sn;
        *(unsigned*)(GT + ((((size_t)(b * 128 + p1)) * 256 + c) * 64 + s2) * 2) = pack2(re2, im2);
      }
  }
  SEG_LOOP(it, 2816, 512) { prep_diff(p, l, it); }
  SEG_LOOP(it, 3328, 4096) { hgrn_h1(p, l, it, sm); }
}

DI void ph_d(const Params& p, int l, u16* sm) {
  char* ws = p.ws;
  SEG_LOOP(tn, 0, 1024) {
    f32x16 acc[2][2]; zero_acc<2>(acc);
    gemm_ml<2>((const u16*)(ws + O_E2), 128, (const u16*)(ws + O_GT) + (size_t)tn * 128 * 128, 128, 128, acc, sm);
    u16* OF = (u16*)(ws + O_OF);
    epi<2>(acc, [&](int m, int n, float v) {
      const int sel = m >> 6, p2 = m & 63;
      const int nn = tn * 128 + n;
      const int b = nn >> 15, p1 = (nn >> 8) & 127, c = nn & 255;
      const size_t tok = (size_t)b * 8192 + p1 + 128 * p2;
      OF[tok * 512 + sel * 256 + c] = f2bf(v);
    });
  }
  SEG_LOOP(it, 1024, 512) { prep_mla(p, l, it); }
  hgrn_h2(p);
}

template <int DK, int NMAP>
DI void attn_core(const u16* __restrict__ Qb, const u16* __restrict__ Kb, long mapstride, const u16* __restrict__ VTb, int q0,
                  f32x16 (&O)[NMAP][2], float (&ls)[NMAP], u16* sm) {
  constexpr int KS = DK / 16, KROW = DK + 8, KT_E = NMAP * 64 * KROW, VROW = 68, BUF = KT_E + 64 * VROW;
  constexpr int KCH = 64 * DK / 8 / 256;
  constexpr int CPR = DK / 8;
  const int tid = tidx(), lane = tid & 63, wave = tid >> 6, l31 = lane & 31, hh = lane >> 5;
  bf16x8 qf[NMAP][KS];
  {
    const int query = q0 + wave * 32 + l31;
#pragma unroll
    for (int mp = 0; mp < NMAP; ++mp)
#pragma unroll
      for (int ks = 0; ks < KS; ++ks) qf[mp][ks] = *(const bf16x8*)(Qb + mp * mapstride + (long)query * DK + ks * 16 + hh * 8);
  }
  uint4 rk[NMAP][KCH], rv[2];
#pragma unroll
  for (int mp = 0; mp < NMAP; ++mp) {
    ls[mp] = 0.f;
#pragma unroll
    for (int dt = 0; dt < 2; ++dt)
#pragma unroll
      for (int r = 0; r < 16; ++r) O[mp][dt][r] = 0.f;
  }
  auto gl = [&](int kt) {
#pragma unroll
    for (int mp = 0; mp < NMAP; ++mp)
#pragma unroll
      for (int i = 0; i < KCH; ++i) rk[mp][i] = *(const uint4*)(Kb + mp * mapstride + (long)kt * 64 * DK + (tid + 256 * i) * 8);
#pragma unroll
    for (int i = 0; i < 2; ++i) {
      const int c = tid + 256 * i, d = c >> 3, cc = c & 7;
      rv[i] = *(const uint4*)(VTb + (long)d * T + kt * 64 + cc * 8);
    }
  };
  auto sw = [&](int buf) {
    u16* ks_ = sm + buf * BUF;
    u16* vs_ = ks_ + KT_E;
#pragma unroll
    for (int mp = 0; mp < NMAP; ++mp)
#pragma unroll
      for (int i = 0; i < KCH; ++i) {
        const int c = tid + 256 * i, row = c / CPR, col = c % CPR;
        *(uint4*)(ks_ + (mp * 64 + row) * KROW + col * 8) = rk[mp][i];
      }
#pragma unroll
    for (int i = 0; i < 2; ++i) {
      const int c = tid + 256 * i, d = c >> 3, cc = c & 7;
      uint2* dst = (uint2*)(vs_ + d * VROW + cc * 8);
      dst[0] = make_uint2(rv[i].x, rv[i].y);
      dst[1] = make_uint2(rv[i].z, rv[i].w);
    }
  };
  gl(0);
  sw(0);
  __syncthreads();
  constexpr int NKT = SEQ / 64;
  for (int kt = 0; kt < NKT; ++kt) {
    const int buf = kt & 1;
    if (kt + 1 < NKT) gl(kt + 1);
    const u16* ks_ = sm + buf * BUF;
    const u16* vs_ = ks_ + KT_E;
#pragma unroll
    for (int sb = 0; sb < 2; ++sb) {
      bf16x8 pf[NMAP][2];
#pragma unroll
      for (int mp = 0; mp < NMAP; ++mp) {
        f32x16 s;
#pragma unroll
        for (int r = 0; r < 16; ++r) s[r] = 0.f;
#pragma unroll
        for (int ks = 0; ks < KS; ++ks) {
          const bf16x8 kf = *(const bf16x8*)(ks_ + (mp * 64 + sb * 32 + l31) * KROW + ks * 16 + hh * 8);
          s = MFMA(kf, qf[mp][ks], s);
        }
        float pr[16];
        float a = 0.f;
#pragma unroll
        for (int r = 0; r < 16; ++r) { pr[r] = __builtin_amdgcn_exp2f(s[r]); a += pr[r]; }
        ls[mp] += a;
        pf[mp][0] = __builtin_bit_cast(bf16x8, pack8(pr));
        pf[mp][1] = __builtin_bit_cast(bf16x8, pack8(pr + 8));
      }
#pragma unroll
      for (int ts = 0; ts < 2; ++ts)
#pragma unroll
        for (int dt = 0; dt < 2; ++dt) {
          const u16* vp = vs_ + (dt * 32 + l31) * VROW + sb * 32 + ts * 16 + hh * 4;
          const s16x4 lo = *(const s16x4*)vp;
          const s16x4 hi = *(const s16x4*)(vp + 8);
          const bf16x8 vf = __builtin_shufflevector(lo, hi, 0, 1, 2, 3, 4, 5, 6, 7);
#pragma unroll
          for (int mp = 0; mp < NMAP; ++mp) O[mp][dt] = MFMA(vf, pf[mp][ts], O[mp][dt]);
        }
    }
    if (kt + 1 < NKT) sw(buf ^ 1);
    __syncthreads();
  }
#pragma unroll
  for (int mp = 0; mp < NMAP; ++mp) ls[mp] += __shfl_xor(ls[mp], 32);
}

DI void attn_mla(const Params& p, int l, int id, u16* sm) {
  char* ws = p.ws;
  const int lane = tidx() & 63, wave = tidx() >> 6, l31 = lane & 31, hh = lane >> 5;
  const int bh = id >> 6, qb = id & 63, b = bh >> 2, hd = bh & 3;
  const int q0 = qb * 128;
  const size_t tok = (size_t)b * 8192 + q0 + wave * 32 + l31;
  f32x16 O[1][2];
  float ls[1];
  attn_core<96, 1>((const u16*)(ws + O_QM) + (size_t)bh * 8192 * 96, (const u16*)(ws + O_KM) + (size_t)bh * 8192 * 96, 0,
                   (const u16*)(ws + O_VMT) + (size_t)(hd * 64) * T + (size_t)b * 8192, q0, O, ls, sm);
  const float inv = 1.f / ls[0];
  u16* dst = (u16*)(ws + O_OM) + tok * 256 + hd * 64;
#pragma unroll
  for (int dt = 0; dt < 2; ++dt)
#pragma unroll
    for (int i = 0; i < 4; ++i) {
      uint2 o;
      o.x = pack2(O[0][dt][4 * i] * inv, O[0][dt][4 * i + 1] * inv);
      o.y = pack2(O[0][dt][4 * i + 2] * inv, O[0][dt][4 * i + 3] * inv);
      *(uint2*)(dst + dt * 32 + 8 * i + 4 * hh) = o;
    }
}

DI void attn_diff(const Params& p, int l, int id, u16* sm) {
  char* ws = p.ws;
  const int lane = tidx() & 63, wave = tidx() >> 6, l31 = lane & 31, hh = lane >> 5;
  const int bh = id >> 6, qb = id & 63, b = bh >> 2, hd = bh & 3;
  const int q0 = qb * 128;
  const size_t tok = (size_t)b * 8192 + q0 + wave * 32 + l31;
  f32x16 O[2][2];
  float ls[2];
  attn_core<32, 2>((const u16*)(ws + O_QD) + (size_t)bh * 2 * 8192 * 32, (const u16*)(ws + O_KD) + (size_t)bh * 2 * 8192 * 32,
                   8192 * 32, (const u16*)(ws + O_VDT) + (size_t)(hd * 64) * T + (size_t)b * 8192, q0, O, ls, sm);
  float d1 = 0.f, d2 = 0.f;
  for (int i = 0; i < 32; ++i) {
    d1 += p.in[11][l * 32 + i] * p.in[12][l * 32 + i];
    d2 += p.in[13][l * 32 + i] * p.in[14][l * 32 + i];
  }
  const float lam_init = 0.8f - 0.6f * expf(-0.3f * (float)l);
  const float lam = expf(d1) - expf(d2) + lam_init;
  const float i1 = 1.f / ls[0], i2 = lam / ls[1];
  float ss = 0.f;
#pragma unroll
  for (int dt = 0; dt < 2; ++dt)
#pragma unroll
    for (int r = 0; r < 16; ++r) {
      const float v = O[0][dt][r] * i1 - O[1][dt][r] * i2;
      O[0][dt][r] = v;
      ss += v * v;
    }
  ss += __shfl_xor(ss, 32);
  const float rr = rsqrtf(ss * (1.f / 64.f) + EPS) * (1.f - lam_init);
  const float* gs = p.in[15] + l * 64;
  u16* dst = (u16*)(ws + O_OD) + tok * 256 + hd * 64;
#pragma unroll
  for (int dt = 0; dt < 2; ++dt)
#pragma unroll
    for (int i = 0; i < 4; ++i) {
      const int d0 = dt * 32 + 8 * i + 4 * hh;
      uint2 o;
      o.x = pack2(O[0][dt][4 * i] * rr * gs[d0], O[0][dt][4 * i + 1] * rr * gs[d0 + 1]);
      o.y = pack2(O[0][dt][4 * i + 2] * rr * gs[d0 + 2], O[0][dt][4 * i + 3] * rr * gs[d0 + 3]);
      *(uint2*)(dst + d0) = o;
    }
}

DI void ph_e(const Params& p, int l, u16* sm) {
#ifndef NO_MLA
  SEG_LOOP(it, 0, 1024) {
    const int xcd = it & 7, q = it >> 3, grp = q >> 6, j = q & 63;
    attn_mla(p, l, (grp * 8 + xcd) * 64 + j, sm);
  }
#endif
#ifndef NO_DIFF
  SEG_LOOP(it, 1024, 1024) {
    const int xcd = it & 7, q = it >> 3, grp = q >> 6, j = q & 63;
    attn_diff(p, l, (grp * 8 + xcd) * 64 + j, sm);
  }
#endif
#ifndef NO_H3
  SEG_LOOP(it, 2048, 2048) { hgrn_h3(p, l, it, sm); }
#endif
}

DI void ph_merge(const Params& p, u16* sm) {
  char* ws = p.ws;
  const u16* H = (const u16*)(ws + O_H);
  u16* MG = (u16*)(ws + O_MG);
  for (int it = bidx(); it < 256 * 16; it += gridDim.x) {
    const int tn = it & 15, tm = it >> 4;
    f32x16 mg[2][1];
    zero_acc<1>(mg);
#pragma unroll 1
    for (int n = 0; n < 4; ++n) {
      f32x16 ag[2][1], ab[2][1];
      zero_acc<1>(ag);
      zero_acc<1>(ab);
      gemm_ml<1>(H + (size_t)tm * 128 * 1024, 1024, (const u16*)(ws + O_WG) + ((size_t)n * 1024 + tn * 64) * 1024, 1024, 1024, ag, sm);
      const size_t oa = n == 0 ? O_OM : (n == 1 ? O_OF : (n == 2 ? O_OD : O_OH));
      const size_t ob = n == 0 ? O_WB0 : (n == 1 ? O_WB1 : (n == 2 ? O_WB2 : O_WB3));
      const int kn = n == 1 ? 512 : 256;
      gemm_ml<1>((const u16*)(ws + oa) + (size_t)tm * 128 * kn, kn, (const u16*)(ws + ob) + (size_t)tn * 64 * kn, kn, kn, ab, sm);
#pragma unroll
      for (int mt = 0; mt < 2; ++mt)
#pragma unroll
        for (int r = 0; r < 16; ++r) mg[mt][0][r] += sigmoid_fast(ag[mt][0][r]) * ab[mt][0][r];
    }
    epi<1>(mg, [&](int m, int n, float v) { MG[(size_t)(tm * 128 + m) * 1024 + tn * 64 + n] = f2bf(v); });
  }
}

DI void ph_resid_gemm(const u16* A, int K, const u16* W, const float* xin, float* xout, u16* sm) {
  for (int it = bidx(); it < 256 * 8; it += gridDim.x) {
    const int tn = it & 7, tm = it >> 3;
    f32x16 acc[2][2];
    zero_acc<2>(acc);
    gemm_ml<2>(A + (size_t)tm * 128 * K, K, W + (size_t)tn * 128 * K, K, K, acc, sm);
    epi<2>(acc, [&](int m, int n, float v) {
      const size_t o = (size_t)(tm * 128 + m) * 1024 + tn * 128 + n;
      xout[o] = xin[o] + v;
    });
  }
}

DI void ph_gateup(const Params& p, u16* sm) {
  char* ws = p.ws;
  const u16* H = (const u16*)(ws + O_H);
  u16* ACT = (u16*)(ws + O_ACT);
  const int lane = tidx() & 63, wave = tidx() >> 6, l31 = lane & 31, hh = lane >> 5, wm = wave >> 1, wn = wave & 1;
  for (int it = bidx(); it < 256 * 44; it += gridDim.x) {
    const int tn = it % 44, tm = it / 44;
    f32x16 acc[2][2];
    zero_acc<2>(acc);
    gemm_ml<2>(H + (size_t)tm * 128 * 1024, 1024, (const u16*)(ws + O_WGU) + (size_t)tn * 128 * 1024, 1024, 1024, acc, sm);
#pragma unroll
    for (int mt = 0; mt < 2; ++mt)
#pragma unroll
      for (int r = 0; r < 16; ++r) {
        const float g = acc[mt][0][r], u = acc[mt][1][r];
        const float a = g * sigmoid_fast(g) * u;
        ACT[(size_t)(tm * 128 + wm * 64 + mt * 32 + crow(r, hh)) * DFF + tn * 64 + wn * 32 + l31] = f2bf(a);
      }
  }
}

constexpr int NPH = 10;
#ifndef LB_MIN
#define LB_MIN 2
#endif

template <bool COOP>
__global__ void __launch_bounds__(256, LB_MIN) mk(Params p, int ph_lo, int ph_hi) {
  __shared__ __attribute__((aligned(16))) u16 sm[SMEM_BYTES / 2];
  char* ws = p.ws;
  for (int ph = ph_lo; ph < ph_hi; ++ph) {
    const int l = ph / NPH, s = ph % NPH;
    const float* xin = l == 0 ? p.in[0] : p.out;
#ifndef ONLY_PHASE
#define ONLY_PHASE -1
#endif
#define PH_ON(x) (ONLY_PHASE < 0 || ONLY_PHASE == (x))
    switch (s) {
      case 0:
        if (!PH_ON(0)) break;
        ph_wprep(p, l);
        ph_rmsnorm(xin, p.in[1] + l * 1024, (u16*)(ws + O_H));
        break;
      case 1: if (PH_ON(1)) ph_inproj(p, sm); break;
      case 2: if (PH_ON(2)) ph_c(p, l, sm); break;
      case 3: if (PH_ON(3)) ph_d(p, l, sm); break;
      case 4: if (PH_ON(4)) ph_e(p, l, sm); break;
      case 5: if (PH_ON(5)) ph_merge(p, sm); break;
      case 6: if (PH_ON(6)) ph_resid_gemm((const u16*)(ws + O_MG), 1024, (const u16*)(ws + O_WO), xin, p.out, sm); break;
      case 7: if (PH_ON(7)) ph_rmsnorm(p.out, p.in[20] + l * 1024, (u16*)(ws + O_H)); break;
      case 8: if (PH_ON(8)) ph_gateup(p, sm); break;
      case 9: if (PH_ON(9)) ph_resid_gemm((const u16*)(ws + O_ACT), DFF, (const u16*)(ws + O_WD), p.out, p.out, sm); break;
    }
    if (COOP) {
      if (ph + 1 < ph_hi) cg::this_grid().sync();
    }
  }
}

extern "C" void kernel_launch(void* const* d_in, const int* in_sizes, int n_in, void* d_out, int out_size, void* d_ws,
                              size_t ws_size, hipStream_t stream) {
  Params p{};
  for (int i = 0; i < 23; ++i) p.in[i] = (const float*)d_in[i];
  p.out = (float*)d_out;
  p.ws = (char*)d_ws;
  if (ws_size < O_END) fprintf(stderr, "workspace too small: %zu < %zu\n", ws_size, (size_t)O_END);
  static int grid_blocks = 0;
  if (!grid_blocks) {
    int dev = 0, cus = 0, per_cu = 0;
    hipGetDevice(&dev);
    hipDeviceGetAttribute(&cus, hipDeviceAttributeMultiprocessorCount, dev);
#if MK_ONE_LAUNCH
    hipOccupancyMaxActiveBlocksPerMultiprocessor(&per_cu, mk<true>, 256, 0);
#else
    hipOccupancyMaxActiveBlocksPerMultiprocessor(&per_cu, mk<false>, 256, 0);
#endif
    if (per_cu < 1) per_cu = 1;
    if (per_cu > 2) per_cu = 2;
    grid_blocks = cus * per_cu;
  }
#if MK_ONE_LAUNCH
  int lo = 0, hi = 2 * NPH;
  void* args[] = {&p, &lo, &hi};
  hipError_t e = hipLaunchCooperativeKernel((void*)mk<true>, dim3(grid_blocks), dim3(256), args, 0, stream);
  if (e != hipSuccess) fprintf(stderr, "cooperative launch failed: %s (grid %d)\n", hipGetErrorString(e), grid_blocks);
#else
  for (int ph = 0; ph < 2 * NPH; ++ph) mk<false><<<grid_blocks, 256, 0, stream>>>(p, ph, ph + 1);
#endif
}
```

```cpp
#include <hip/hip_runtime.h>
#include <hip/hip_cooperative_groups.h>
#include <cstdio>
namespace cg = cooperative_groups;

#ifndef MK_ONE_LAUNCH
#define MK_ONE_LAUNCH 1
#endif

#define DI __device__ __forceinline__
typedef unsigned short u16;
typedef __bf16 bf2_t __attribute__((ext_vector_type(2)));
typedef float f2_t __attribute__((ext_vector_type(2)));
using bf16x8 = __attribute__((ext_vector_type(8))) short;
using s16x4 = __attribute__((ext_vector_type(4))) short;
using f32x16 = __attribute__((ext_vector_type(16))) float;
using u32x4 = __attribute__((ext_vector_type(4))) unsigned;
#define MFMA(a, b, c) __builtin_amdgcn_mfma_f32_32x32x16_bf16((a), (b), (c), 0, 0, 0)

constexpr int T = 32768, SEQ = 8192, ZW = 2336, INW = 6944, DFF = 2816;
constexpr float EPS = 1e-6f;
constexpr float LOG2E = 1.4426950408889634f;

constexpr size_t O_WZ = 0;
constexpr size_t O_WF = O_WZ + 2432ull * 1024 * 2;
constexpr size_t O_WG = O_WF + 512ull * 1024 * 2;
constexpr size_t O_WUQ = O_WG + 4096ull * 1024 * 2;
constexpr size_t O_WKN = O_WUQ + 384ull * 384 * 2;
constexpr size_t O_WV = O_WKN + 256ull * 128 * 2;
constexpr size_t O_WB0 = O_WV + 256ull * 128 * 2;
constexpr size_t O_WB1 = O_WB0 + 1024ull * 256 * 2;
constexpr size_t O_WB2 = O_WB1 + 1024ull * 512 * 2;
constexpr size_t O_WB3 = O_WB2 + 1024ull * 256 * 2;
constexpr size_t O_WO = O_WB3 + 1024ull * 256 * 2;
constexpr size_t O_WGU = O_WO + 1024ull * 1024 * 2;
constexpr size_t O_WD = O_WGU + 5632ull * 1024 * 2;
constexpr size_t O_RC = O_WD + 1024ull * 2816 * 2;
constexpr size_t O_RS = O_RC + 8192ull * 16 * 4;
constexpr size_t O_E1 = O_RS + 8192ull * 16 * 4;
constexpr size_t O_E2 = O_E1 + 256ull * 128 * 2;
constexpr size_t O_H = O_E2 + 128ull * 128 * 2;
constexpr size_t O_OF = O_H + (size_t)T * 1024 * 2;
constexpr size_t O_Z = O_OF + (size_t)T * 512 * 2;
constexpr size_t O_UT = O_Z + (size_t)T * ZW * 2;
constexpr size_t O_QM = O_UT;
constexpr size_t O_GT = O_UT + (size_t)T * 384 * 2;
constexpr size_t O_OH = O_GT;
constexpr size_t O_VDT = O_GT + (size_t)T * 512 * 2;
constexpr size_t O_QRAW = O_VDT + (size_t)T * 256 * 2;
constexpr size_t O_OM = O_QRAW;
constexpr size_t O_KN = O_QRAW + (size_t)T * 384 * 2;
constexpr size_t O_OD = O_KN;
constexpr size_t O_VMT = O_KN + (size_t)T * 256 * 2;
constexpr size_t O_KM = O_VMT + (size_t)T * 256 * 2;
constexpr size_t O_QD = O_KM + (size_t)T * 384 * 2;
constexpr size_t O_KD = O_QD + (size_t)T * 256 * 2;
constexpr size_t O_ST = O_KD + (size_t)T * 256 * 2;
constexpr size_t O_DEC = O_ST + 4096ull * 4096 * 2;
constexpr size_t O_END = O_DEC + 4096ull * 64 * 4;
constexpr size_t O_MG = O_Z;
constexpr size_t O_ACT = O_Z;

constexpr int SMEM_BYTES = 73728 + 1024;

struct Params {
  const float* in[23];
  float* out;
  char* ws;
};

DI int tidx() { int t = threadIdx.x; asm volatile("" : "+v"(t)); return t; }
DI int bidx() { int t = blockIdx.x; asm volatile("" : "+s"(t)); return t; }
DI float bf2f(u16 v) { return __uint_as_float(((unsigned)v) << 16); }
DI float bflo(unsigned v) { return __uint_as_float(v << 16); }
DI float bfhi(unsigned v) { return __uint_as_float(v & 0xffff0000u); }
DI unsigned pack2(float a, float b) {
  f2_t v = {a, b};
  return __builtin_bit_cast(unsigned, __builtin_convertvector(v, bf2_t));
}
DI u16 f2bf(float a) { return (u16)(pack2(a, 0.f) & 0xffffu); }
DI float sigmoid_fast(float x) { return __builtin_amdgcn_rcpf(1.f + __expf(-x)); }
DI int crow(int r, int hh) { return (r & 3) + 8 * (r >> 2) + 4 * hh; }
DI void unpack8(const uint4& v, float* x) {
  x[0] = bflo(v.x); x[1] = bfhi(v.x); x[2] = bflo(v.y); x[3] = bfhi(v.y);
  x[4] = bflo(v.z); x[5] = bfhi(v.z); x[6] = bflo(v.w); x[7] = bfhi(v.w);
}
DI uint4 pack8(const float* x) {
  uint4 o; o.x = pack2(x[0], x[1]); o.y = pack2(x[2], x[3]); o.z = pack2(x[4], x[5]); o.w = pack2(x[6], x[7]);
  return o;
}

template <int WN, int PF = 2>
DI void gemm_ml(const u16* __restrict__ A, long lda, const u16* __restrict__ B, long ldb, int K,
                f32x16 (&acc)[2][WN], u16* sm) {
  const int tid = tidx(), lane = tid & 63, wave = tid >> 6, l31 = lane & 31, hh = lane >> 5;
  const int wm = wave >> 1, wn = wave & 1;
  const int chunk = tid & 7, row0 = tid >> 3;
  u16* sa = sm;
  u16* sb = sm + 2 * 128 * 72;
  struct Stg { u32x4 a0, a1, a2, a3, b0, b1, b2, b3; };
  Stg r0, r1;
  const u16* ga = A + (long)row0 * lda + chunk * 8;
  const u16* gb = B + (long)row0 * ldb + chunk * 8;
  const int nk = K >> 6;
#define GLOAD(R, kt_)                                            \
  {                                                              \
    const int ko = (kt_) * 64;                                   \
    R.a0 = *(const u32x4*)(ga + ko);                             \
    R.a1 = *(const u32x4*)(ga + 32 * lda + ko);                  \
    R.a2 = *(const u32x4*)(ga + 64 * lda + ko);                  \
    R.a3 = *(const u32x4*)(ga + 96 * lda + ko);                  \
    R.b0 = *(const u32x4*)(gb + ko);                             \
    R.b1 = *(const u32x4*)(gb + 32 * ldb + ko);                  \
    if (WN == 2) {                                               \
      R.b2 = *(const u32x4*)(gb + 64 * ldb + ko);                \
      R.b3 = *(const u32x4*)(gb + 96 * ldb + ko);                \
    }                                                            \
  }
#define SWRITE(R, buf_)                                                   \
  {                                                                       \
    u16* wa = sa + (buf_) * 128 * 72 + row0 * 72 + chunk * 8;             \
    u16* wb = sb + (buf_) * 128 * 72 + row0 * 72 + chunk * 8;             \
    *(u32x4*)(wa) = R.a0;                                                 \
    *(u32x4*)(wa + 32 * 72) = R.a1;                                       \
    *(u32x4*)(wa + 64 * 72) = R.a2;                                       \
    *(u32x4*)(wa + 96 * 72) = R.a3;                                       \
    *(u32x4*)(wb) = R.b0;                                                 \
    *(u32x4*)(wb + 32 * 72) = R.b1;                                       \
    if (WN == 2) {                                                        \
      *(u32x4*)(wb + 64 * 72) = R.b2;                                     \
      *(u32x4*)(wb + 96 * 72) = R.b3;                                     \
    }                                                                     \
  }
  auto compute = [&](int buf) {
    const u16* pa = sa + buf * 128 * 72 + (wm * 64 + l31) * 72 + hh * 8;
    const u16* pb = sb + buf * 128 * 72 + (wn * 32 * WN + l31) * 72 + hh * 8;
#pragma unroll
    for (int ks = 0; ks < 4; ++ks) {
      bf16x8 af[2], bfr[WN];
#pragma unroll
      for (int mt = 0; mt < 2; ++mt) af[mt] = *(const bf16x8*)(pa + mt * 32 * 72 + ks * 16);
#pragma unroll
      for (int nt = 0; nt < WN; ++nt) bfr[nt] = *(const bf16x8*)(pb + nt * 32 * 72 + ks * 16);
#pragma unroll
      for (int mt = 0; mt < 2; ++mt)
#pragma unroll
        for (int nt = 0; nt < WN; ++nt) acc[mt][nt] = MFMA(af[mt], bfr[nt], acc[mt][nt]);
    }
  };
  if (PF == 2) {
    GLOAD(r0, 0);
    if (nk > 1) GLOAD(r1, 1);
    SWRITE(r0, 0);
    __syncthreads();
#pragma unroll 1
    for (int kt = 0; kt < nk; kt += 2) {
      if (kt + 2 < nk) GLOAD(r0, kt + 2);
      compute(0);
      if (kt + 1 < nk) SWRITE(r1, 1);
      __syncthreads();
      if (kt + 1 >= nk) break;
      if (kt + 3 < nk) GLOAD(r1, kt + 3);
      compute(1);
      if (kt + 2 < nk) SWRITE(r0, 0);
      __syncthreads();
    }
  } else {
    GLOAD(r0, 0);
    SWRITE(r0, 0);
    __syncthreads();
#pragma unroll 1
    for (int kt = 0; kt < nk; ++kt) {
      const int buf = kt & 1;
      if (kt + 1 < nk) GLOAD(r0, kt + 1);
      compute(buf);
      if (kt + 1 < nk) SWRITE(r0, buf ^ 1);
      __syncthreads();
    }
  }
#undef GLOAD
#undef SWRITE
}

template <int WN>
DI void zero_acc(f32x16 (&acc)[2][WN]) {
#pragma unroll
  for (int mt = 0; mt < 2; ++mt)
#pragma unroll
    for (int nt = 0; nt < WN; ++nt)
#pragma unroll
      for (int r = 0; r < 16; ++r) acc[mt][nt][r] = 0.f;
}

template <int WN, class F>
DI void epi(f32x16 (&acc)[2][WN], F f) {
  const int lane = tidx() & 63, wave = tidx() >> 6, l31 = lane & 31, hh = lane >> 5;
  const int wm = wave >> 1, wn = wave & 1;
#pragma unroll
  for (int mt = 0; mt < 2; ++mt)
#pragma unroll
    for (int nt = 0; nt < WN; ++nt)
#pragma unroll
      for (int r = 0; r < 16; ++r)
        f(wm * 64 + mt * 32 + crow(r, hh), wn * 32 * WN + nt * 32 + l31, acc[mt][nt][r]);
}

DI void block_rstd(const u16* base, long ld, int ncols, float* out) {
  const int tid = tidx(), row = tid >> 1, half = tid & 1;
  const int n2 = ncols >> 1;
  const u16* p = base + (long)row * ld + half * n2;
  float ss = 0.f;
  for (int i = 0; i < n2; i += 8) {
    uint4 v = *(const uint4*)(p + i);
    float x[8]; unpack8(v, x);
#pragma unroll
    for (int j = 0; j < 8; ++j) ss += x[j] * x[j];
  }
  ss += __shfl_xor(ss, 1);
  if (half == 0) out[row] = rsqrtf(ss / (float)ncols + EPS);
}

template <class CM, class SC>
DI void convT(u16* dst, int N, int K, const float* __restrict__ src, long ld, CM cm, SC sc) {
  const long total = (long)N * K / 8;
  const int kbn = K / 32;
  for (long i = bidx() * 256L + tidx(); i < total; i += gridDim.x * 256L) {
    const int kq = (int)(i & 3), nl = (int)((i >> 2) & 15);
    const long rest = i >> 6;
    const int kb = (int)(rest % kbn), nb = (int)(rest / kbn);
    const int n = nb * 16 + nl, k0 = kb * 32 + kq * 8;
    const int c = cm(n);
    float v[8];
#pragma unroll
    for (int j = 0; j < 8; ++j) v[j] = (c >= 0) ? src[(long)(k0 + j) * ld + c] * sc(k0 + j) : 0.f;
    *(uint4*)(dst + (long)n * K + k0) = pack8(v);
  }
}

DI void ph_wprep(const Params& p, int l) {
  char* ws = p.ws;
  auto one = [](int) { return 1.f; };
  const float* w_in = p.in[2] + (size_t)l * 1024 * INW;
  convT((u16*)(ws + O_WZ), 2432, 1024, w_in, INW,
        [](int n) { return n < 544 ? n : (n < 1056 ? n + 256 : (n < ZW ? n + 512 : -1)); }, one);
  convT((u16*)(ws + O_WF), 512, 1024, w_in, INW, [](int n) { return n < 256 ? 544 + n : 1312 + (n - 256); }, one);
  convT((u16*)(ws + O_WG), 4096, 1024, w_in, INW, [](int n) { return 2848 + n; }, one);
  {
    const float* g = p.in[3] + l * 384;
    convT((u16*)(ws + O_WUQ), 384, 384, p.in[4] + (size_t)l * 384 * 384, 384, [](int n) { return n; },
          [g](int k) { return g[k]; });
  }
  {
    const float* g = p.in[5] + l * 128;
    const float* w = p.in[6] + (size_t)l * 128 * 512;
    convT((u16*)(ws + O_WKN), 256, 128, w, 512, [](int n) { return (n >> 6) * 128 + (n & 63); }, [g](int k) { return g[k]; });
    convT((u16*)(ws + O_WV), 256, 128, w, 512, [](int n) { return (n >> 6) * 128 + 64 + (n & 63); }, [g](int k) { return g[k]; });
  }
  const float* wb = p.in[18] + (size_t)l * 4 * 256 * 1024;
  convT((u16*)(ws + O_WB0), 1024, 256, wb, 1024, [](int n) { return n; }, one);
  convT((u16*)(ws + O_WB2), 1024, 256, wb + 2 * 256 * 1024, 1024, [](int n) { return n; }, one);
  convT((u16*)(ws + O_WB3), 1024, 256, wb + 3 * 256 * 1024, 1024, [](int n) { return n; }, one);
  convT((u16*)(ws + O_WO), 1024, 1024, p.in[19] + (size_t)l * 1024 * 1024, 1024, [](int n) { return n; }, one);
  convT((u16*)(ws + O_WGU), 5632, 1024, p.in[21] + (size_t)l * 1024 * 5632, 5632,
        [](int R) {
          const int tile = R >> 7, w = R & 127;
          const int col = tile * 64 + (w >> 6) * 32 + (w & 31);
          return ((w >> 5) & 1) ? DFF + col : col;
        },
        one);
  convT((u16*)(ws + O_WD), 1024, 2816, p.in[22] + (size_t)l * DFF * 1024, 1024, [](int n) { return n; }, one);
  {
    u16* dst = (u16*)(ws + O_WB1);
    const float* w1 = wb + 1 * 256 * 1024;
    for (int i = bidx() * 256 + tidx(); i < 1024 * 512; i += gridDim.x * 256) {
      const int j = i & 1023, kk = i >> 10;
      const int sel = kk >> 8, g = (kk >> 6) & 3, cc = kk & 63;
      float a = 0.f;
      for (int c2 = 0; c2 < 64; ++c2) {
        const float fr = (float)((cc * c2) & 63) * (1.f / 64.f);
        const float tr = sel ? -__builtin_amdgcn_sinf(fr) : __builtin_amdgcn_cosf(fr);
        a += tr * w1[(g * 64 + c2) * 1024 + j];
      }
      dst[j * 512 + kk] = f2bf(a * 0.125f);
    }
  }
  if (l == 0) {
    float* rc = (float*)(ws + O_RC);
    float* rs = (float*)(ws + O_RS);
    for (int i = bidx() * 256 + tidx(); i < 8192 * 16; i += gridDim.x * 256) {
      const int pos = i >> 4, fi = i & 15;
      const float invf = 1.0f / exp2f((float)fi * 0.8304820237218407f);
      const float ang = (float)pos * invf;
      double rv = (double)ang * 0.15915494309189535;
      rv -= floor(rv);
      const float fr = (float)rv;
      rc[i] = __builtin_amdgcn_cosf(fr);
      rs[i] = __builtin_amdgcn_sinf(fr);
    }
    u16* e1 = (u16*)(ws + O_E1);
    for (int i = bidx() * 256 + tidx(); i < 256 * 128; i += gridDim.x * 256) {
      const int R = i >> 7, s1 = i & 127;
      const int p1 = (R >> 7) * 64 + ((R >> 6) & 1) * 32 + (R & 31), ri = (R >> 5) & 1;
      const float fr = (float)((p1 * s1) & 127) * (1.f / 128.f);
      const float v = ri ? -__builtin_amdgcn_sinf(fr) : __builtin_amdgcn_cosf(fr);
      e1[i] = f2bf(v * 0.08838834764831845f);
    }
    u16* e2 = (u16*)(ws + O_E2);
    for (int i = bidx() * 256 + tidx(); i < 128 * 128; i += gridDim.x * 256) {
      const int R = i >> 7, kk = i & 127;
      const int sel = R >> 6, p2 = R & 63, s2 = kk >> 1, ri = kk & 1;
      const float fr = (float)((p2 * s2) & 63) * (1.f / 64.f);
      const float c = __builtin_amdgcn_cosf(fr), s = __builtin_amdgcn_sinf(fr);
      const float v = sel == 0 ? (ri == 0 ? c : s) : (ri == 0 ? s : -c);
      e2[i] = f2bf(v * 0.125f);
    }
  }
}

DI void ph_rmsnorm(const float* __restrict__ x, const float* __restrict__ g, u16* __restrict__ H) {
  const int lane = tidx() & 63, wave = tidx() >> 6;
  for (int row = bidx() * 4 + wave; row < T; row += gridDim.x * 4) {
    const float4* xr = (const float4*)(x + (size_t)row * 1024);
    float4 v[4];
    float ss = 0.f;
#pragma unroll
    for (int i = 0; i < 4; ++i) {
      v[i] = xr[lane + 64 * i];
      ss += v[i].x * v[i].x + v[i].y * v[i].y + v[i].z * v[i].z + v[i].w * v[i].w;
    }
#pragma unroll
    for (int o = 32; o >= 1; o >>= 1) ss += __shfl_xor(ss, o);
    const float r = rsqrtf(ss * (1.f / 1024.f) + EPS);
#pragma unroll
    for (int i = 0; i < 4; ++i) {
      const float4 gg = ((const float4*)g)[lane + 64 * i];
      uint2 o;
      o.x = pack2(v[i].x * r * gg.x, v[i].y * r * gg.y);
      o.y = pack2(v[i].z * r * gg.z, v[i].w * r * gg.w);
      *(uint2*)(H + (size_t)row * 1024 + (lane + 64 * i) * 4) = o;
    }
  }
}

DI void ph_inproj(const Params& p, u16* sm) {
  char* ws = p.ws;
  const u16* H = (const u16*)(ws + O_H);
  u16* Z = (u16*)(ws + O_Z);
  u16* UT = (u16*)(ws + O_UT);
  u16* VDT = (u16*)(ws + O_VDT);
  constexpr int NA = 256 * 19, NB = 4 * 256;
  for (int it = bidx(); it < NA + NB; it += gridDim.x) {
    f32x16 acc[2][2];
    zero_acc<2>(acc);
    if (it < NA) {
      const int tn = it % 19, tm = it / 19;
      gemm_ml<2>(H + (size_t)tm * 128 * 1024, 1024, (const u16*)(ws + O_WZ) + (size_t)tn * 128 * 1024, 1024, 1024, acc, sm);
      epi<2>(acc, [&](int m, int n, float v) {
        const int col = tn * 128 + n;
        if (col < ZW) Z[(size_t)(tm * 128 + m) * ZW + col] = f2bf(v);
      });
    } else {
      const int j = it - NA;
      const int tmf = j & 3, nt = j >> 2;
      const u16* A = (const u16*)(ws + O_WF) + (size_t)tmf * 128 * 1024;
      if (tmf < 2) {
        const int b = nt >> 6, s2 = nt & 63;
        gemm_ml<2>(A, 1024, H + ((size_t)b * 8192 + s2) * 1024, 64 * 1024, 1024, acc, sm);
        epi<2>(acc, [&](int m, int n, float v) {
          const int c = tmf * 128 + m;
          UT[(((size_t)b * 256 + c) * 64 + s2) * 128 + n] = f2bf(v);
        });
      } else {
        gemm_ml<2>(A, 1024, H + (size_t)nt * 128 * 1024, 1024, 1024, acc, sm);
        epi<2>(acc, [&](int m, int n, float v) {
          const int feat = (tmf - 2) * 128 + m;
          VDT[(size_t)feat * T + nt * 128 + n] = f2bf(v);
        });
      }
    }
  }
}

DI float hgrn_lb(const Params& p, int l, int dir, int ch) {
  if (l == 0) return 0.f;
  const float* lg = p.in[16] + dir * 2 * 256;
  const float x0 = lg[ch], x1 = lg[256 + ch];
  return 1.f / (1.f + expf(x0 - x1));
}

DI void hgrn_gates(const u16* zcol  , float lb, int dir, int w, int k, float* tot  ,
                   float (&cum)[16], float (&kk)[16], float& total) {
  float lf[16];
#pragma unroll
  for (int j = 0; j < 16; ++j) {
    const float z = bf2f(zcol[(size_t)(w * 16 + j) * ZW]);
    const float sg = 1.f / (1.f + expf(-z));
    const float f = lb + (1.f - lb) * sg;
    lf[j] = logf(f);
    kk[j] = 1.f - f;
  }
  float pre[16];
  float run = 0.f;
#pragma unroll
  for (int j = 0; j < 16; ++j) { run += lf[j]; pre[j] = run; }
  tot[w * 64 + k] = run;
  __syncthreads();
  const float t0 = tot[k], t1 = tot[64 + k], t2 = tot[128 + k], t3 = tot[192 + k];
  total = t0 + t1 + t2 + t3;
  float before = 0.f;
  if (w > 0) before += t0;
  if (w > 1) before += t1;
  if (w > 2) before += t2;
  const float after = total - before - run;
#pragma unroll
  for (int j = 0; j < 16; ++j) cum[j] = dir ? (after + run - pre[j] + lf[j]) : (before + pre[j]);
}

DI void hgrn_h1(const Params& p, int l, int item, u16* sm) {
  char* ws = p.ws;
  const u16* Z = (const u16*)(ws + O_Z);
  u16* ST = (u16*)(ws + O_ST);
  float* DEC = (float*)(ws + O_DEC);
  const int chunk = item & 127, dir = (item >> 7) & 1, h = (item >> 8) & 3, b = item >> 10;
  const int tid = tidx(), k = tid & 63, w = tid >> 6, lane = tid & 63, l31 = lane & 31, hh = lane >> 5;
  const size_t tok0 = (size_t)b * 8192 + chunk * 64;
  u16* KT = sm;
  u16* VT = sm + 64 * 72;
  float* tot = (float*)(sm + 2 * 64 * 72);
  float cum[16], kk[16], total;
  hgrn_gates(Z + tok0 * ZW + (dir ? 1824 : 1568) + h * 64 + k, hgrn_lb(p, l, dir, h * 64 + k), dir, w, k, tot, cum, kk, total);
  float kv[16], vv[16];
#pragma unroll
  for (int j = 0; j < 16; ++j) {
    kv[j] = kk[j] * expf(total - cum[j]);
    vv[j] = bf2f(Z[(tok0 + w * 16 + j) * ZW + 1312 + h * 64 + k]);
  }
  *(uint4*)(KT + k * 72 + w * 16) = pack8(kv);
  *(uint4*)(KT + k * 72 + w * 16 + 8) = pack8(kv + 8);
  *(uint4*)(VT + k * 72 + w * 16) = pack8(vv);
  *(uint4*)(VT + k * 72 + w * 16 + 8) = pack8(vv + 8);
  if (w == 0) DEC[(size_t)item * 64 + k] = expf(total);
  __syncthreads();
  const int mt = w >> 1, nt = w & 1;
  f32x16 acc;
#pragma unroll
  for (int r = 0; r < 16; ++r) acc[r] = 0.f;
#pragma unroll
  for (int ks = 0; ks < 4; ++ks) {
    const bf16x8 a = *(const bf16x8*)(VT + (mt * 32 + l31) * 72 + ks * 16 + hh * 8);
    const bf16x8 bq = *(const bf16x8*)(KT + (nt * 32 + l31) * 72 + ks * 16 + hh * 8);
    acc = MFMA(a, bq, acc);
  }
#pragma unroll
  for (int r = 0; r < 16; ++r) ST[(size_t)item * 4096 + (mt * 32 + crow(r, hh)) * 64 + nt * 32 + l31] = f2bf(acc[r]);
  __syncthreads();
}

DI void hgrn_h2(const Params& p) {
  char* ws = p.ws;
  u16* ST = (u16*)(ws + O_ST);
  const float* DEC = (const float*)(ws + O_DEC);
  for (int pi = bidx() * 256 + tidx(); pi < 32 * 2048; pi += gridDim.x * 256) {
    const int chain = pi >> 11, e2 = pi & 2047, dir = chain & 1;
    const int k = (2 * e2) & 63;
    float s0 = 0.f, s1 = 0.f;
#pragma unroll 8
    for (int c = 0; c < 128; ++c) {
      const int chunk = dir ? 127 - c : c;
      const size_t item = (size_t)chain * 128 + chunk;
      unsigned* ptr = (unsigned*)(ST + item * 4096 + 2 * e2);
      const unsigned u = *ptr;
      const float2 d = *(const float2*)(DEC + item * 64 + k);
      *ptr = pack2(s0, s1);
      s0 = d.x * s0 + bflo(u);
      s1 = d.y * s1 + bfhi(u);
    }
  }
}

DI void hgrn_h3(const Params& p, int l, int item, u16* sm) {
  char* ws = p.ws;
  const u16* Z = (const u16*)(ws + O_Z);
  const u16* ST = (const u16*)(ws + O_ST);
  u16* OH = (u16*)(ws + O_OH);
  const int chunk = item & 127, h = (item >> 7) & 3, b = item >> 9;
  const int tid = tidx(), k = tid & 63, w = tid >> 6, lane = tid & 63, l31 = lane & 31, hh = lane >> 5;
  const size_t tok0 = (size_t)b * 8192 + chunk * 64;
  u16* Q1 = sm;
  u16* Q2 = sm + 64 * 72;
  u16* KT = sm + 2 * 64 * 72;
  u16* VT = sm + 3 * 64 * 72;
  float* tot = (float*)(sm + 4 * 64 * 72);
  float* ssum = tot + 256;
  const int vt = w >> 1, tt = w & 1;
  {
    float vv[16];
#pragma unroll
    for (int j = 0; j < 16; ++j) vv[j] = bf2f(Z[(tok0 + w * 16 + j) * ZW + 1312 + h * 64 + k]);
    *(uint4*)(VT + k * 72 + w * 16) = pack8(vv);
    *(uint4*)(VT + k * 72 + w * 16 + 8) = pack8(vv + 8);
  }
  f32x16 O;
#pragma unroll
  for (int r = 0; r < 16; ++r) O[r] = 0.f;
  for (int dir = 0; dir < 2; ++dir) {
    float cum[16], kk[16], total;
    hgrn_gates(Z + tok0 * ZW + (dir ? 1824 : 1568) + h * 64 + k, hgrn_lb(p, l, dir, h * 64 + k), dir, w, k, tot, cum, kk, total);
    const float ref = 0.5f * total;
#pragma unroll
    for (int j = 0; j < 16; ++j) {
      const int t = w * 16 + j;
      const float q = bf2f(Z[(tok0 + t) * ZW + 1056 + h * 64 + k]);
      Q1[t * 72 + k] = f2bf(q * expf(cum[j] - ref));
      Q2[t * 72 + k] = f2bf(q * expf(cum[j]));
      KT[t * 72 + k] = f2bf(kk[j] * expf(ref - cum[j]));
    }
    __syncthreads();
    const size_t sti = ((size_t)((b * 4 + h) * 2 + dir) * 128 + chunk) * 4096;
#pragma unroll
    for (int sb = 0; sb < 2; ++sb) {
      f32x16 sc;
#pragma unroll
      for (int r = 0; r < 16; ++r) sc[r] = 0.f;
#pragma unroll
      for (int ks = 0; ks < 4; ++ks) {
        const bf16x8 a = *(const bf16x8*)(KT + (sb * 32 + l31) * 72 + ks * 16 + hh * 8);
        const bf16x8 bq = *(const bf16x8*)(Q1 + (tt * 32 + l31) * 72 + ks * 16 + hh * 8);
        sc = MFMA(a, bq, sc);
      }
      const int tcol = tt * 32 + l31;
      float pm[16];
#pragma unroll
      for (int r = 0; r < 16; ++r) {
        const int srow = sb * 32 + crow(r, hh);
        const bool keep = dir ? (srow >= tcol) : (srow <= tcol);
        pm[r] = keep ? sc[r] : 0.f;
      }
#pragma unroll
      for (int ts = 0; ts < 2; ++ts) {
        const uint4 pk = pack8(pm + 8 * ts);
        const bf16x8 pf = __builtin_bit_cast(bf16x8, pk);
        const u16* vp = VT + (vt * 32 + l31) * 72 + sb * 32 + ts * 16 + hh * 4;
        const s16x4 lo = *(const s16x4*)vp;
        const s16x4 hi = *(const s16x4*)(vp + 8);
        const bf16x8 vf = __builtin_shufflevector(lo, hi, 0, 1, 2, 3, 4, 5, 6, 7);
        O = MFMA(vf, pf, O);
      }
    }
#pragma unroll
    for (int ks = 0; ks < 4; ++ks) {
      const bf16x8 a = *(const bf16x8*)(ST + sti + (vt * 32 + l31) * 64 + ks * 16 + hh * 8);
      const bf16x8 bq = *(const bf16x8*)(Q2 + (tt * 32 + l31) * 72 + ks * 16 + hh * 8);
      O = MFMA(a, bq, O);
    }
    __syncthreads();
  }
  float ss = 0.f;
#pragma unroll
  for (int r = 0; r < 16; ++r) ss += O[r] * O[r];
  ss += __shfl_xor(ss, 32);
  if (hh == 0) ssum[vt * 64 + tt * 32 + l31] = ss;
  __syncthreads();
  const float rr = rsqrtf((ssum[tt * 32 + l31] + ssum[64 + tt * 32 + l31]) * (1.f / 64.f) + EPS);
  const size_t tok = tok0 + tt * 32 + l31;
  const float* gon = p.in[17] + l * 64;
#pragma unroll
  for (int i = 0; i < 4; ++i) {
    const int v0 = vt * 32 + 8 * i + 4 * hh;
    const uint2 hg = *(const uint2*)(Z + tok * ZW + 2080 + h * 64 + v0);
    const float g0 = 1.f / (1.f + expf(-bflo(hg.x))), g1 = 1.f / (1.f + expf(-bfhi(hg.x)));
    const float g2 = 1.f / (1.f + expf(-bflo(hg.y))), g3 = 1.f / (1.f + expf(-bfhi(hg.y)));
    uint2 o;
    o.x = pack2(O[4 * i + 0] * rr * gon[v0 + 0] * g0, O[4 * i + 1] * rr * gon[v0 + 1] * g1);
    o.y = pack2(O[4 * i + 2] * rr * gon[v0 + 2] * g2, O[4 * i + 3] * rr * gon[v0 + 3] * g3);
    *(uint2*)(OH + tok * 256 + h * 64 + v0) = o;
  }
  __syncthreads();
}

DI void prep_diff(const Params& p, int l, int blk) {
  char* ws = p.ws;
  const u16* Z = (const u16*)(ws + O_Z);
  const float* rc = (const float*)(ws + O_RC);
  const float* rs = (const float*)(ws + O_RS);
  for (int g = 0; g < 4; ++g) {
    const int isk = g >> 1;
    const int idx = tidx() + 256 * (g & 1);
    const int tl = idx >> 3, j = idx & 7;
    const int tok = blk * 64 + tl, b = tok >> 13, s = tok & 8191;
    const u16* src = Z + (size_t)tok * ZW + (isk ? 800 : 544) + j * 32;
    const float* gain = p.in[isk ? 10 : 9] + l * 32;
    float x[32];
#pragma unroll
    for (int i = 0; i < 4; ++i) unpack8(*(const uint4*)(src + 8 * i), x + 8 * i);
    float ss = 0.f;
#pragma unroll
    for (int i = 0; i < 32; ++i) ss += x[i] * x[i];
    const float r = rsqrtf(ss * (1.f / 32.f) + EPS);
#pragma unroll
    for (int i = 0; i < 32; ++i) x[i] = x[i] * r * gain[i];
    const float sc = isk ? 1.f : 0.17677669529663687f * LOG2E;
#pragma unroll
    for (int i = 0; i < 16; ++i) {
      const float c = rc[s * 16 + i], sn = rs[s * 16 + i];
      const float a = x[i], bb = x[i + 16];
      x[i] = (a * c - bb * sn) * sc;
      x[i + 16] = (a * sn + bb * c) * sc;
    }
    const int hd = j >> 1, mp = j & 1;
    u16* dst = (u16*)(ws + (isk ? O_KD : O_QD)) + ((((size_t)b * 4 + hd) * 2 + mp) * 8192 + s) * 32;
#pragma unroll
    for (int i = 0; i < 4; ++i) *(uint4*)(dst + 8 * i) = pack8(x + 8 * i);
  }
}

DI void prep_mla(const Params& p, int l, int blk) {
  char* ws = p.ws;
  const u16* Z = (const u16*)(ws + O_Z);
  const float* rc = (const float*)(ws + O_RC);
  const float* rs = (const float*)(ws + O_RS);
  const int tl = tidx() >> 2, hd = tidx() & 3;
  const int tok = blk * 64 + tl, b = tok >> 13, s = tok & 8191;
  for (int isk = 0; isk < 2; ++isk) {
    float x[96];
    if (!isk) {
      const u16* src = (const u16*)(ws + O_QRAW) + (size_t)tok * 384 + hd * 96;
#pragma unroll
      for (int i = 0; i < 12; ++i) unpack8(*(const uint4*)(src + 8 * i), x + 8 * i);
    } else {
      const u16* src = (const u16*)(ws + O_KN) + (size_t)tok * 256 + hd * 64;
#pragma unroll
      for (int i = 0; i < 8; ++i) unpack8(*(const uint4*)(src + 8 * i), x + 8 * i);
      const u16* src2 = Z + (size_t)tok * ZW + 512;
#pragma unroll
      for (int i = 0; i < 4; ++i) unpack8(*(const uint4*)(src2 + 8 * i), x + 64 + 8 * i);
    }
    const float* gain = p.in[isk ? 8 : 7] + l * 96;
    float ss = 0.f;
#pragma unroll
    for (int i = 0; i < 96; ++i) ss += x[i] * x[i];
    const float r = rsqrtf(ss * (1.f / 96.f) + EPS);
#pragma unroll
    for (int i = 0; i < 96; ++i) x[i] = x[i] * r * gain[i];
    const float sc = isk ? 1.f : 0.10206207261596575f * LOG2E;
#pragma unroll
    for (int i = 0; i < 64; ++i) x[i] *= sc;
#pragma unroll
    for (int i = 0; i < 16; ++i) {
      const float c = rc[s * 16 + i], sn = rs[s * 16 + i];
      const float a = x[64 + i], bb = x[80 + i];
      x[64 + i] = (a * c - bb * sn) * sc;
      x[80 + i] = (a * sn + bb * c) * sc;
    }
    u16* dst = (u16*)(ws + (isk ? O_KM : O_QM)) + (((size_t)b * 4 + hd) * 8192 + s) * 96;
#pragma unroll
    for (int i = 0; i < 12; ++i) *(uint4*)(dst + 8 * i) = pack8(x + 8 * i);
  }
}

#define SEG_LOOP(it, base, n) \
  _Pragma("unroll 1") for (int it = (int)((bidx() + gridDim.x - ((base) % gridDim.x)) % gridDim.x); it < (n); it += gridDim.x)

DI void ph_c(const Params& p, int l, u16* sm) {
  char* ws = p.ws;
  const u16* Z = (const u16*)(ws + O_Z);
  float* rstd = (float*)((char*)sm + 73728);
  SEG_LOOP(it, 0, 768) {
    const int tn = it % 3, tm = it / 3;
    f32x16 acc[2][2]; zero_acc<2>(acc);
    const u16* A = Z + (size_t)tm * 128 * ZW;
    block_rstd(A, ZW, 384, rstd);
    gemm_ml<2, 1>(A, ZW, (const u16*)(ws + O_WUQ) + (size_t)tn * 128 * 384, 384, 384, acc, sm);
    u16* dst = (u16*)(ws + O_QRAW);
    epi<2>(acc, [&](int m, int n, float v) { dst[(size_t)(tm * 128 + m) * 384 + tn * 128 + n] = f2bf(v * rstd[m]); });
    __syncthreads();
  }
  SEG_LOOP(it, 768, 512) {
    const int tn = it & 1, tm = it >> 1;
    f32x16 acc[2][2]; zero_acc<2>(acc);
    const u16* A = Z + (size_t)tm * 128 * ZW + 384;
    block_rstd(A, ZW, 128, rstd);
    gemm_ml<2, 1>(A, ZW, (const u16*)(ws + O_WKN) + (size_t)tn * 128 * 128, 128, 128, acc, sm);
    u16* dst = (u16*)(ws + O_KN);
    epi<2>(acc, [&](int m, int n, float v) { dst[(size_t)(tm * 128 + m) * 256 + tn * 128 + n] = f2bf(v * rstd[m]); });
    __syncthreads();
  }
  SEG_LOOP(it, 1280, 512) {
    const int tmf = it & 1, nt = it >> 1;
    f32x16 acc[2][2]; zero_acc<2>(acc);
    const u16* B = Z + (size_t)nt * 128 * ZW + 384;
    block_rstd(B, ZW, 128, rstd);
    gemm_ml<2, 1>((const u16*)(ws + O_WV) + (size_t)tmf * 128 * 128, 128, B, ZW, 128, acc, sm);
    u16* dst = (u16*)(ws + O_VMT);
    epi<2>(acc, [&](int m, int n, float v) { dst[(size_t)(tmf * 128 + m) * T + nt * 128 + n] = f2bf(v * rstd[n]); });
    __syncthreads();
  }
  SEG_LOOP(it, 1792, 1024) {
    const int tmE = it & 1, tn = it >> 1;
    f32x16 acc[2][2]; zero_acc<2>(acc);
    gemm_ml<2, 1>((const u16*)(ws + O_E1) + (size_t)tmE * 128 * 128, 128, (const u16*)(ws + O_UT) + (size_t)tn * 128 * 128, 128, 128, acc, sm);
    u16* GT = (u16*)(ws + O_GT);
    const int lane = tidx() & 63, wave = tidx() >> 6, l31 = lane & 31, hh = lane >> 5, wm = wave >> 1, wn = wave & 1;
#pragma unroll
    for (int nt = 0; nt < 2; ++nt)
#pragma unroll
      for (int r = 0; r < 16; ++r) {
        const float re = acc[0][nt][r], im = acc[1][nt][r];
        const int p1 = tmE * 64 + wm * 32 + crow(r, hh);
        const int n = tn * 128 + wn * 64 + nt * 32 + l31;
        const int b = n >> 14, c = (n >> 6) & 255, s2 = n & 63;
        const float fr = (float)(s2 * p1) * (1.f / 8192.f);
        const float cs = __builtin_amdgcn_cosf(fr), sn = __builtin_amdgcn_sinf(fr);
        const float re2 = re * cs + im * sn, im2 = im * cs - re * sn;
        *(unsigned*)(GT + ((((size_t)(b * 128 + p1)) * 256 + c) * 64 + s2) * 2) = pack2(re2, im2);
      }
  }
  SEG_LOOP(it, 2816, 512) { prep_diff(p, l, it); }
  SEG_LOOP(it, 3328, 4096) { hgrn_h1(p, l, it, sm); }
}

DI void ph_d(const Params& p, int l, u16* sm) {
  char* ws = p.ws;
  SEG_LOOP(tn, 0, 1024) {
    f32x16 acc[2][2]; zero_acc<2>(acc);
    gemm_ml<2, 1>((const u16*)(ws + O_E2), 128, (const u16*)(ws + O_GT) + (size_t)tn * 128 * 128, 128, 128, acc, sm);
    u16* OF = (u16*)(ws + O_OF);
    epi<2>(acc, [&](int m, int n, float v) {
      const int sel = m >> 6, p2 = m & 63;
      const int nn = tn * 128 + n;
      const int b = nn >> 15, p1 = (nn >> 8) & 127, c = nn & 255;
      const size_t tok = (size_t)b * 8192 + p1 + 128 * p2;
      OF[tok * 512 + sel * 256 + c] = f2bf(v);
    });
  }
  SEG_LOOP(it, 1024, 512) { prep_mla(p, l, it); }
  hgrn_h2(p);
}

template <int DK, int NMAP>
DI void attn_core(const u16* __restrict__ Qb, const u16* __restrict__ Kb, long mapstride, const u16* __restrict__ VTb, int q0,
                  f32x16 (&O)[NMAP][2], float (&ls)[NMAP], u16* sm) {
  constexpr int KS = DK / 16, KROW = DK + 8, KT_E = NMAP * 64 * KROW, VROW = 68, BUF = KT_E + 64 * VROW;
  constexpr int KCH = 64 * DK / 8 / 256;
  constexpr int CPR = DK / 8;
  const int tid = tidx(), lane = tid & 63, wave = tid >> 6, l31 = lane & 31, hh = lane >> 5;
  bf16x8 qf[NMAP][KS];
  {
    const int query = q0 + wave * 32 + l31;
#pragma unroll
    for (int mp = 0; mp < NMAP; ++mp)
#pragma unroll
      for (int ks = 0; ks < KS; ++ks) qf[mp][ks] = *(const bf16x8*)(Qb + mp * mapstride + (long)query * DK + ks * 16 + hh * 8);
  }
  uint4 rk[NMAP][KCH], rv[2];
#pragma unroll
  for (int mp = 0; mp < NMAP; ++mp) {
    ls[mp] = 0.f;
#pragma unroll
    for (int dt = 0; dt < 2; ++dt)
#pragma unroll
      for (int r = 0; r < 16; ++r) O[mp][dt][r] = 0.f;
  }
  auto gl = [&](int kt) {
#pragma unroll
    for (int mp = 0; mp < NMAP; ++mp)
#pragma unroll
      for (int i = 0; i < KCH; ++i) rk[mp][i] = *(const uint4*)(Kb + mp * mapstride + (long)kt * 64 * DK + (tid + 256 * i) * 8);
#pragma unroll
    for (int i = 0; i < 2; ++i) {
      const int c = tid + 256 * i, d = c >> 3, cc = c & 7;
      rv[i] = *(const uint4*)(VTb + (long)d * T + kt * 64 + cc * 8);
    }
  };
  auto sw = [&](int buf) {
    u16* ks_ = sm + buf * BUF;
    u16* vs_ = ks_ + KT_E;
#pragma unroll
    for (int mp = 0; mp < NMAP; ++mp)
#pragma unroll
      for (int i = 0; i < KCH; ++i) {
        const int c = tid + 256 * i, row = c / CPR, col = c % CPR;
        *(uint4*)(ks_ + (mp * 64 + row) * KROW + col * 8) = rk[mp][i];
      }
#pragma unroll
    for (int i = 0; i < 2; ++i) {
      const int c = tid + 256 * i, d = c >> 3, cc = c & 7;
      uint2* dst = (uint2*)(vs_ + d * VROW + cc * 8);
      dst[0] = make_uint2(rv[i].x, rv[i].y);
      dst[1] = make_uint2(rv[i].z, rv[i].w);
    }
  };
  gl(0);
  sw(0);
  __syncthreads();
  constexpr int NKT = SEQ / 64;
  for (int kt = 0; kt < NKT; ++kt) {
    const int buf = kt & 1;
    if (kt + 1 < NKT) gl(kt + 1);
    const u16* ks_ = sm + buf * BUF;
    const u16* vs_ = ks_ + KT_E;
#pragma unroll
    for (int sb = 0; sb < 2; ++sb) {
      bf16x8 pf[NMAP][2];
#pragma unroll
      for (int mp = 0; mp < NMAP; ++mp) {
        f32x16 s;
#pragma unroll
        for (int r = 0; r < 16; ++r) s[r] = 0.f;
#pragma unroll
        for (int ks = 0; ks < KS; ++ks) {
          const bf16x8 kf = *(const bf16x8*)(ks_ + (mp * 64 + sb * 32 + l31) * KROW + ks * 16 + hh * 8);
          s = MFMA(kf, qf[mp][ks], s);
        }
        float pr[16];
        float a = 0.f;
#pragma unroll
        for (int r = 0; r < 16; ++r) { pr[r] = __builtin_amdgcn_exp2f(s[r]); a += pr[r]; }
        ls[mp] += a;
        pf[mp][0] = __builtin_bit_cast(bf16x8, pack8(pr));
        pf[mp][1] = __builtin_bit_cast(bf16x8, pack8(pr + 8));
      }
#pragma unroll
      for (int ts = 0; ts < 2; ++ts)
#pragma unroll
        for (int dt = 0; dt < 2; ++dt) {
          const u16* vp = vs_ + (dt * 32 + l31) * VROW + sb * 32 + ts * 16 + hh * 4;
          const s16x4 lo = *(const s16x4*)vp;
          const s16x4 hi = *(const s16x4*)(vp + 8);
          const bf16x8 vf = __builtin_shufflevector(lo, hi, 0, 1, 2, 3, 4, 5, 6, 7);
#pragma unroll
          for (int mp = 0; mp < NMAP; ++mp) O[mp][dt] = MFMA(vf, pf[mp][ts], O[mp][dt]);
        }
    }
    if (kt + 1 < NKT) sw(buf ^ 1);
    __syncthreads();
  }
#pragma unroll
  for (int mp = 0; mp < NMAP; ++mp) ls[mp] += __shfl_xor(ls[mp], 32);
}

DI void attn_mla(const Params& p, int l, int id, u16* sm) {
  char* ws = p.ws;
  const int lane = tidx() & 63, wave = tidx() >> 6, l31 = lane & 31, hh = lane >> 5;
  const int bh = id >> 6, qb = id & 63, b = bh >> 2, hd = bh & 3;
  const int q0 = qb * 128;
  const size_t tok = (size_t)b * 8192 + q0 + wave * 32 + l31;
  f32x16 O[1][2];
  float ls[1];
  attn_core<96, 1>((const u16*)(ws + O_QM) + (size_t)bh * 8192 * 96, (const u16*)(ws + O_KM) + (size_t)bh * 8192 * 96, 0,
                   (const u16*)(ws + O_VMT) + (size_t)(hd * 64) * T + (size_t)b * 8192, q0, O, ls, sm);
  const float inv = 1.f / ls[0];
  u16* dst = (u16*)(ws + O_OM) + tok * 256 + hd * 64;
#pragma unroll
  for (int dt = 0; dt < 2; ++dt)
#pragma unroll
    for (int i = 0; i < 4; ++i) {
      uint2 o;
      o.x = pack2(O[0][dt][4 * i] * inv, O[0][dt][4 * i + 1] * inv);
      o.y = pack2(O[0][dt][4 * i + 2] * inv, O[0][dt][4 * i + 3] * inv);
      *(uint2*)(dst + dt * 32 + 8 * i + 4 * hh) = o;
    }
}

DI void attn_diff(const Params& p, int l, int id, u16* sm) {
  char* ws = p.ws;
  const int lane = tidx() & 63, wave = tidx() >> 6, l31 = lane & 31, hh = lane >> 5;
  const int bh = id >> 6, qb = id & 63, b = bh >> 2, hd = bh & 3;
  const int q0 = qb * 128;
  const size_t tok = (size_t)b * 8192 + q0 + wave * 32 + l31;
  f32x16 O[2][2];
  float ls[2];
  attn_core<32, 2>((const u16*)(ws + O_QD) + (size_t)bh * 2 * 8192 * 32, (const u16*)(ws + O_KD) + (size_t)bh * 2 * 8192 * 32,
                   8192 * 32, (const u16*)(ws + O_VDT) + (size_t)(hd * 64) * T + (size_t)b * 8192, q0, O, ls, sm);
  float d1 = 0.f, d2 = 0.f;
  for (int i = 0; i < 32; ++i) {
    d1 += p.in[11][l * 32 + i] * p.in[12][l * 32 + i];
    d2 += p.in[13][l * 32 + i] * p.in[14][l * 32 + i];
  }
  const float lam_init = 0.8f - 0.6f * expf(-0.3f * (float)l);
  const float lam = expf(d1) - expf(d2) + lam_init;
  const float i1 = 1.f / ls[0], i2 = lam / ls[1];
  float ss = 0.f;
#pragma unroll
  for (int dt = 0; dt < 2; ++dt)
#pragma unroll
    for (int r = 0; r < 16; ++r) {
      const float v = O[0][dt][r] * i1 - O[1][dt][r] * i2;
      O[0][dt][r] = v;
      ss += v * v;
    }
  ss += __shfl_xor(ss, 32);
  const float rr = rsqrtf(ss * (1.f / 64.f) + EPS) * (1.f - lam_init);
  const float* gs = p.in[15] + l * 64;
  u16* dst = (u16*)(ws + O_OD) + tok * 256 + hd * 64;
#pragma unroll
  for (int dt = 0; dt < 2; ++dt)
#pragma unroll
    for (int i = 0; i < 4; ++i) {
      const int d0 = dt * 32 + 8 * i + 4 * hh;
      uint2 o;
      o.x = pack2(O[0][dt][4 * i] * rr * gs[d0], O[0][dt][4 * i + 1] * rr * gs[d0 + 1]);
      o.y = pack2(O[0][dt][4 * i + 2] * rr * gs[d0 + 2], O[0][dt][4 * i + 3] * rr * gs[d0 + 3]);
      *(uint2*)(dst + d0) = o;
    }
}

DI void ph_e(const Params& p, int l, u16* sm) {
#ifndef NO_MLA
  SEG_LOOP(it, 0, 1024) {
    const int xcd = it & 7, q = it >> 3, grp = q >> 6, j = q & 63;
    attn_mla(p, l, (grp * 8 + xcd) * 64 + j, sm);
  }
#endif
#ifndef NO_DIFF
  SEG_LOOP(it, 1024, 1024) {
    const int xcd = it & 7, q = it >> 3, grp = q >> 6, j = q & 63;
    attn_diff(p, l, (grp * 8 + xcd) * 64 + j, sm);
  }
#endif
#ifndef NO_H3
  SEG_LOOP(it, 2048, 2048) { hgrn_h3(p, l, it, sm); }
#endif
}

DI void ph_merge(const Params& p, u16* sm) {
  char* ws = p.ws;
  const u16* H = (const u16*)(ws + O_H);
  u16* MG = (u16*)(ws + O_MG);
#pragma unroll 1
  for (int it = bidx(); it < 256 * 8; it += gridDim.x) {
    const int tn = it & 7, tm = it >> 3;
    unsigned mgp[2][2][8];
#pragma unroll
    for (int mt = 0; mt < 2; ++mt)
#pragma unroll
      for (int nt = 0; nt < 2; ++nt)
#pragma unroll
        for (int r = 0; r < 8; ++r) mgp[mt][nt][r] = 0u;
#pragma unroll 1
    for (int n = 0; n < 4; ++n) {
      unsigned bp[2][2][8];
      {
        f32x16 ab[2][2];
        zero_acc<2>(ab);
        const size_t oa = n == 0 ? O_OM : (n == 1 ? O_OF : (n == 2 ? O_OD : O_OH));
        const size_t ob = n == 0 ? O_WB0 : (n == 1 ? O_WB1 : (n == 2 ? O_WB2 : O_WB3));
        const int kn = n == 1 ? 512 : 256;
        gemm_ml<2>((const u16*)(ws + oa) + (size_t)tm * 128 * kn, kn, (const u16*)(ws + ob) + (size_t)tn * 128 * kn, kn, kn, ab, sm);
#pragma unroll
        for (int mt = 0; mt < 2; ++mt)
#pragma unroll
          for (int nt = 0; nt < 2; ++nt)
#pragma unroll
            for (int r = 0; r < 8; ++r) bp[mt][nt][r] = pack2(ab[mt][nt][2 * r], ab[mt][nt][2 * r + 1]);
      }
      f32x16 ag[2][2];
      zero_acc<2>(ag);
      gemm_ml<2, 1>(H + (size_t)tm * 128 * 1024, 1024, (const u16*)(ws + O_WG) + ((size_t)n * 1024 + tn * 128) * 1024, 1024, 1024, ag, sm);
#pragma unroll
      for (int mt = 0; mt < 2; ++mt)
#pragma unroll
        for (int nt = 0; nt < 2; ++nt)
#pragma unroll
          for (int r = 0; r < 8; ++r) {
            const float m0 = bflo(mgp[mt][nt][r]) + sigmoid_fast(ag[mt][nt][2 * r]) * bflo(bp[mt][nt][r]);
            const float m1 = bfhi(mgp[mt][nt][r]) + sigmoid_fast(ag[mt][nt][2 * r + 1]) * bfhi(bp[mt][nt][r]);
            mgp[mt][nt][r] = pack2(m0, m1);
          }
    }
    {
      const int lane = tidx() & 63, wave = tidx() >> 6, l31 = lane & 31, hh = lane >> 5, wm = wave >> 1, wn = wave & 1;
#pragma unroll
      for (int mt = 0; mt < 2; ++mt)
#pragma unroll
        for (int nt = 0; nt < 2; ++nt)
#pragma unroll
          for (int r = 0; r < 8; ++r) {
            const size_t row = (size_t)(tm * 128 + wm * 64 + mt * 32 + crow(2 * r, hh));
            const int col = tn * 128 + wn * 64 + nt * 32 + l31;
            MG[row * 1024 + col] = (u16)(mgp[mt][nt][r] & 0xffffu);
            MG[(row + 1) * 1024 + col] = (u16)(mgp[mt][nt][r] >> 16);
          }
    }
  }
}

DI void ph_resid_gemm(const u16* A, int K, const u16* W, const float* xin, float* xout, u16* sm) {
  for (int it = bidx(); it < 256 * 8; it += gridDim.x) {
    const int tn = it & 7, tm = it >> 3;
    f32x16 acc[2][2];
    zero_acc<2>(acc);
    gemm_ml<2>(A + (size_t)tm * 128 * K, K, W + (size_t)tn * 128 * K, K, K, acc, sm);
    epi<2>(acc, [&](int m, int n, float v) {
      const size_t o = (size_t)(tm * 128 + m) * 1024 + tn * 128 + n;
      xout[o] = xin[o] + v;
    });
  }
}

DI void ph_gateup(const Params& p, u16* sm) {
  char* ws = p.ws;
  const u16* H = (const u16*)(ws + O_H);
  u16* ACT = (u16*)(ws + O_ACT);
  const int lane = tidx() & 63, wave = tidx() >> 6, l31 = lane & 31, hh = lane >> 5, wm = wave >> 1, wn = wave & 1;
  for (int it = bidx(); it < 256 * 44; it += gridDim.x) {
    const int tn = it % 44, tm = it / 44;
    f32x16 acc[2][2];
    zero_acc<2>(acc);
    gemm_ml<2>(H + (size_t)tm * 128 * 1024, 1024, (const u16*)(ws + O_WGU) + (size_t)tn * 128 * 1024, 1024, 1024, acc, sm);
#pragma unroll
    for (int mt = 0; mt < 2; ++mt)
#pragma unroll
      for (int r = 0; r < 16; ++r) {
        const float g = acc[mt][0][r], u = acc[mt][1][r];
        const float a = g * sigmoid_fast(g) * u;
        ACT[(size_t)(tm * 128 + wm * 64 + mt * 32 + crow(r, hh)) * DFF + tn * 64 + wn * 32 + l31] = f2bf(a);
      }
  }
}

constexpr int NPH = 10;
#ifndef LB_MIN
#define LB_MIN 2
#endif

template <bool COOP>
__global__ void __launch_bounds__(256, LB_MIN) mk(Params p, int ph_lo, int ph_hi) {
  __shared__ __attribute__((aligned(16))) u16 sm[SMEM_BYTES / 2];
  char* ws = p.ws;
#ifndef PROBE_MASK
#define PROBE_MASK 0
#endif
  int rr = 0;
  (void)rr;
  for (int ph = ph_lo; ph < ph_hi; ++ph) {
    const int l = ph / NPH, s = ph % NPH;
    const float* xin = l == 0 ? p.in[0] : p.out;
#ifndef ONLY_PHASE
#define ONLY_PHASE -1
#endif
#define PH_ON(x) (ONLY_PHASE < 0 || ONLY_PHASE == (x))
    switch (s) {
      case 0:
        if (!PH_ON(0)) break;
        ph_wprep(p, l);
        ph_rmsnorm(xin, p.in[1] + l * 1024, (u16*)(ws + O_H));
        break;
      case 1: if (PH_ON(1)) ph_inproj(p, sm); break;
      case 2: if (PH_ON(2)) ph_c(p, l, sm); break;
      case 3: if (PH_ON(3)) ph_d(p, l, sm); break;
      case 4: if (PH_ON(4)) ph_e(p, l, sm); break;
      case 5: if (PH_ON(5)) ph_merge(p, sm); break;
      case 6: if (PH_ON(6)) ph_resid_gemm((const u16*)(ws + O_MG), 1024, (const u16*)(ws + O_WO), xin, p.out, sm); break;
      case 7: if (PH_ON(7)) ph_rmsnorm(p.out, p.in[20] + l * 1024, (u16*)(ws + O_H)); break;
      case 8: if (PH_ON(8)) ph_gateup(p, sm); break;
      case 9: if (PH_ON(9)) ph_resid_gemm((const u16*)(ws + O_ACT), DFF, (const u16*)(ws + O_WD), p.out, p.out, sm); break;
    }
    if (COOP) {
      if (ph + 1 < ph_hi) cg::this_grid().sync();
    }
#if PROBE_MASK
    if (COOP && rr == 0 && ph < NPH && ((PROBE_MASK >> ph) & 1)) { rr = 1; --ph; } else rr = 0;
#endif
  }
}

extern "C" void kernel_launch(void* const* d_in, const int* in_sizes, int n_in, void* d_out, int out_size, void* d_ws,
                              size_t ws_size, hipStream_t stream) {
  Params p{};
  for (int i = 0; i < 23; ++i) p.in[i] = (const float*)d_in[i];
  p.out = (float*)d_out;
  p.ws = (char*)d_ws;
  if (ws_size < O_END) fprintf(stderr, "workspace too small: %zu < %zu\n", ws_size, (size_t)O_END);
  static int grid_blocks = 0;
  if (!grid_blocks) {
    int dev = 0, cus = 0, per_cu = 0;
    hipGetDevice(&dev);
    hipDeviceGetAttribute(&cus, hipDeviceAttributeMultiprocessorCount, dev);
#if MK_ONE_LAUNCH
    hipOccupancyMaxActiveBlocksPerMultiprocessor(&per_cu, mk<true>, 256, 0);
#else
    hipOccupancyMaxActiveBlocksPerMultiprocessor(&per_cu, mk<false>, 256, 0);
#endif
    if (per_cu < 1) per_cu = 1;
    if (per_cu > 2) per_cu = 2;
    grid_blocks = cus * per_cu;
  }
#if MK_ONE_LAUNCH
  int lo = 0, hi = 2 * NPH;
  void* args[] = {&p, &lo, &hi};
  hipError_t e = hipLaunchCooperativeKernel((void*)mk<true>, dim3(grid_blocks), dim3(256), args, 0, stream);
  if (e != hipSuccess) fprintf(stderr, "cooperative launch failed: %s (grid %d)\n", hipGetErrorString(e), grid_blocks);
#else
  for (int ph = 0; ph < 2 * NPH; ++ph) mk<false><<<grid_blocks, 256, 0, stream>>>(p, ph, ph + 1);
#endif
}
```

```cpp
#include <hip/hip_runtime.h>
#include <hip/hip_cooperative_groups.h>
#include <cstdio>
namespace cg = cooperative_groups;

#ifndef MK_ONE_LAUNCH
#define MK_ONE_LAUNCH 1
#endif

#define DI __device__ __forceinline__
typedef unsigned short u16;
typedef __bf16 bf2_t __attribute__((ext_vector_type(2)));
typedef float f2_t __attribute__((ext_vector_type(2)));
using bf16x8 = __attribute__((ext_vector_type(8))) short;
using s16x4 = __attribute__((ext_vector_type(4))) short;
using f32x16 = __attribute__((ext_vector_type(16))) float;
using u32x4 = __attribute__((ext_vector_type(4))) unsigned;
#define MFMA(a, b, c) __builtin_amdgcn_mfma_f32_32x32x16_bf16((a), (b), (c), 0, 0, 0)

constexpr int T = 32768, SEQ = 8192, ZW = 2336, INW = 6944, DFF = 2816;
constexpr float EPS = 1e-6f;
constexpr float LOG2E = 1.4426950408889634f;

constexpr size_t O_WZ = 0;
constexpr size_t O_WF = O_WZ + 2432ull * 1024 * 2;
constexpr size_t O_WG = O_WF + 512ull * 1024 * 2;
constexpr size_t O_WUQ = O_WG + 4096ull * 1024 * 2;
constexpr size_t O_WKN = O_WUQ + 384ull * 384 * 2;
constexpr size_t O_WV = O_WKN + 256ull * 128 * 2;
constexpr size_t O_WB0 = O_WV + 256ull * 128 * 2;
constexpr size_t O_WB1 = O_WB0 + 1024ull * 256 * 2;
constexpr size_t O_WB2 = O_WB1 + 1024ull * 512 * 2;
constexpr size_t O_WB3 = O_WB2 + 1024ull * 256 * 2;
constexpr size_t O_WO = O_WB3 + 1024ull * 256 * 2;
constexpr size_t O_WGU = O_WO + 1024ull * 1024 * 2;
constexpr size_t O_WD = O_WGU + 5632ull * 1024 * 2;
constexpr size_t O_RC = O_WD + 1024ull * 2816 * 2;
constexpr size_t O_RS = O_RC + 8192ull * 16 * 4;
constexpr size_t O_E1 = O_RS + 8192ull * 16 * 4;
constexpr size_t O_E2 = O_E1 + 256ull * 128 * 2;
constexpr size_t O_H = O_E2 + 128ull * 128 * 2;
constexpr size_t O_OF = O_H + (size_t)T * 1024 * 2;
constexpr size_t O_Z = O_OF + (size_t)T * 512 * 2;
constexpr size_t O_UT = O_Z + (size_t)T * ZW * 2;
constexpr size_t O_QM = O_UT;
constexpr size_t O_GT = O_UT + (size_t)T * 384 * 2;
constexpr size_t O_OH = O_GT;
constexpr size_t O_VDT = O_GT + (size_t)T * 512 * 2;
constexpr size_t O_QRAW = O_VDT + (size_t)T * 256 * 2;
constexpr size_t O_OM = O_QRAW;
constexpr size_t O_KN = O_QRAW + (size_t)T * 384 * 2;
constexpr size_t O_OD = O_KN;
constexpr size_t O_VMT = O_KN + (size_t)T * 256 * 2;
constexpr size_t O_KM = O_VMT + (size_t)T * 256 * 2;
constexpr size_t O_QD = O_KM + (size_t)T * 384 * 2;
constexpr size_t O_KD = O_QD + (size_t)T * 256 * 2;
constexpr size_t O_ST = O_KD + (size_t)T * 256 * 2;
constexpr size_t O_DEC = O_ST + 4096ull * 4096 * 2;
constexpr size_t O_END = O_DEC + 4096ull * 64 * 4;
constexpr size_t O_MG = O_Z;
constexpr size_t O_ACT = O_Z;

constexpr int SMEM_BYTES = 73728 + 1024;

struct Params {
  const float* in[23];
  float* out;
  char* ws;
};

DI int tidx() { int t = threadIdx.x; asm volatile("" : "+v"(t)); return t; }
DI int bidx() { int t = blockIdx.x; asm volatile("" : "+s"(t)); return t; }
DI float bf2f(u16 v) { return __uint_as_float(((unsigned)v) << 16); }
DI float bflo(unsigned v) { return __uint_as_float(v << 16); }
DI float bfhi(unsigned v) { return __uint_as_float(v & 0xffff0000u); }
DI unsigned pack2(float a, float b) {
  f2_t v = {a, b};
  return __builtin_bit_cast(unsigned, __builtin_convertvector(v, bf2_t));
}
DI u16 f2bf(float a) { return (u16)(pack2(a, 0.f) & 0xffffu); }
DI float sigmoid_fast(float x) { return __builtin_amdgcn_rcpf(1.f + __expf(-x)); }
DI int crow(int r, int hh) { return (r & 3) + 8 * (r >> 2) + 4 * hh; }
DI void unpack8(const uint4& v, float* x) {
  x[0] = bflo(v.x); x[1] = bfhi(v.x); x[2] = bflo(v.y); x[3] = bfhi(v.y);
  x[4] = bflo(v.z); x[5] = bfhi(v.z); x[6] = bflo(v.w); x[7] = bfhi(v.w);
}
DI uint4 pack8(const float* x) {
  uint4 o; o.x = pack2(x[0], x[1]); o.y = pack2(x[2], x[3]); o.z = pack2(x[4], x[5]); o.w = pack2(x[6], x[7]);
  return o;
}

template <int WN, int PF = 2>
DI void gemm_ml(const u16* __restrict__ A, long lda, const u16* __restrict__ B, long ldb, int K,
                f32x16 (&acc)[2][WN], u16* sm) {
  const int tid = tidx(), lane = tid & 63, wave = tid >> 6, l31 = lane & 31, hh = lane >> 5;
  const int wm = wave >> 1, wn = wave & 1;
  const int chunk = tid & 7, row0 = tid >> 3;
  u16* sa = sm;
  u16* sb = sm + 2 * 128 * 72;
  struct Stg { u32x4 a0, a1, a2, a3, b0, b1, b2, b3; };
  Stg r0, r1;
  const u16* ga = A + (long)row0 * lda + chunk * 8;
  const u16* gb = B + (long)row0 * ldb + chunk * 8;
  const int nk = K >> 6;
#define GLOAD(R, kt_)                                            \
  {                                                              \
    const int ko = (kt_) * 64;                                   \
    R.a0 = *(const u32x4*)(ga + ko);                             \
    R.a1 = *(const u32x4*)(ga + 32 * lda + ko);                  \
    R.a2 = *(const u32x4*)(ga + 64 * lda + ko);                  \
    R.a3 = *(const u32x4*)(ga + 96 * lda + ko);                  \
    R.b0 = *(const u32x4*)(gb + ko);                             \
    R.b1 = *(const u32x4*)(gb + 32 * ldb + ko);                  \
    if (WN == 2) {                                               \
      R.b2 = *(const u32x4*)(gb + 64 * ldb + ko);                \
      R.b3 = *(const u32x4*)(gb + 96 * ldb + ko);                \
    }                                                            \
  }
#define SWRITE(R, buf_)                                                   \
  {                                                                       \
    u16* wa = sa + (buf_) * 128 * 72 + row0 * 72 + chunk * 8;             \
    u16* wb = sb + (buf_) * 128 * 72 + row0 * 72 + chunk * 8;             \
    *(u32x4*)(wa) = R.a0;                                                 \
    *(u32x4*)(wa + 32 * 72) = R.a1;                                       \
    *(u32x4*)(wa + 64 * 72) = R.a2;                                       \
    *(u32x4*)(wa + 96 * 72) = R.a3;                                       \
    *(u32x4*)(wb) = R.b0;                                                 \
    *(u32x4*)(wb + 32 * 72) = R.b1;                                       \
    if (WN == 2) {                                                        \
      *(u32x4*)(wb + 64 * 72) = R.b2;                                     \
      *(u32x4*)(wb + 96 * 72) = R.b3;                                     \
    }                                                                     \
  }
  auto compute = [&](int buf) {
    const u16* pa = sa + buf * 128 * 72 + (wm * 64 + l31) * 72 + hh * 8;
    const u16* pb = sb + buf * 128 * 72 + (wn * 32 * WN + l31) * 72 + hh * 8;
#pragma unroll
    for (int ks = 0; ks < 4; ++ks) {
      bf16x8 af[2], bfr[WN];
#pragma unroll
      for (int mt = 0; mt < 2; ++mt) af[mt] = *(const bf16x8*)(pa + mt * 32 * 72 + ks * 16);
#pragma unroll
      for (int nt = 0; nt < WN; ++nt) bfr[nt] = *(const bf16x8*)(pb + nt * 32 * 72 + ks * 16);
#pragma unroll
      for (int mt = 0; mt < 2; ++mt)
#pragma unroll
        for (int nt = 0; nt < WN; ++nt) acc[mt][nt] = MFMA(af[mt], bfr[nt], acc[mt][nt]);
    }
  };
  if (PF == 2) {
    GLOAD(r0, 0);
    if (nk > 1) GLOAD(r1, 1);
    SWRITE(r0, 0);
    __syncthreads();
#pragma unroll 1
    for (int kt = 0; kt < nk; kt += 2) {
      if (kt + 2 < nk) GLOAD(r0, kt + 2);
      compute(0);
      if (kt + 1 < nk) SWRITE(r1, 1);
      __syncthreads();
      if (kt + 1 >= nk) break;
      if (kt + 3 < nk) GLOAD(r1, kt + 3);
      compute(1);
      if (kt + 2 < nk) SWRITE(r0, 0);
      __syncthreads();
    }
  } else {
    GLOAD(r0, 0);
    SWRITE(r0, 0);
    __syncthreads();
#pragma unroll 1
    for (int kt = 0; kt < nk; ++kt) {
      const int buf = kt & 1;
      if (kt + 1 < nk) GLOAD(r0, kt + 1);
      compute(buf);
      if (kt + 1 < nk) SWRITE(r0, buf ^ 1);
      __syncthreads();
    }
  }
#undef GLOAD
#undef SWRITE
}

template <int WN>
DI void zero_acc(f32x16 (&acc)[2][WN]) {
#pragma unroll
  for (int mt = 0; mt < 2; ++mt)
#pragma unroll
    for (int nt = 0; nt < WN; ++nt)
#pragma unroll
      for (int r = 0; r < 16; ++r) acc[mt][nt][r] = 0.f;
}

template <int WN, class F>
DI void epi(f32x16 (&acc)[2][WN], F f) {
  const int lane = tidx() & 63, wave = tidx() >> 6, l31 = lane & 31, hh = lane >> 5;
  const int wm = wave >> 1, wn = wave & 1;
#pragma unroll
  for (int mt = 0; mt < 2; ++mt)
#pragma unroll
    for (int nt = 0; nt < WN; ++nt)
#pragma unroll
      for (int r = 0; r < 16; ++r)
        f(wm * 64 + mt * 32 + crow(r, hh), wn * 32 * WN + nt * 32 + l31, acc[mt][nt][r]);
}

DI void block_rstd(const u16* base, long ld, int ncols, float* out) {
  const int tid = tidx(), row = tid >> 1, half = tid & 1;
  const int n2 = ncols >> 1;
  const u16* p = base + (long)row * ld + half * n2;
  float ss = 0.f;
  for (int i = 0; i < n2; i += 8) {
    uint4 v = *(const uint4*)(p + i);
    float x[8]; unpack8(v, x);
#pragma unroll
    for (int j = 0; j < 8; ++j) ss += x[j] * x[j];
  }
  ss += __shfl_xor(ss, 1);
  if (half == 0) out[row] = rsqrtf(ss / (float)ncols + EPS);
}

template <class CM, class SC>
DI void convT(u16* dst, int N, int K, const float* __restrict__ src, long ld, CM cm, SC sc) {
  const long total = (long)N * K / 8;
  const int kbn = K / 32;
  for (long i = bidx() * 256L + tidx(); i < total; i += gridDim.x * 256L) {
    const int kq = (int)(i & 3), nl = (int)((i >> 2) & 15);
    const long rest = i >> 6;
    const int kb = (int)(rest % kbn), nb = (int)(rest / kbn);
    const int n = nb * 16 + nl, k0 = kb * 32 + kq * 8;
    const int c = cm(n);
    float v[8];
#pragma unroll
    for (int j = 0; j < 8; ++j) v[j] = (c >= 0) ? src[(long)(k0 + j) * ld + c] * sc(k0 + j) : 0.f;
    *(uint4*)(dst + (long)n * K + k0) = pack8(v);
  }
}

DI void ph_wprep(const Params& p, int l) {
  char* ws = p.ws;
  auto one = [](int) { return 1.f; };
  const float* w_in = p.in[2] + (size_t)l * 1024 * INW;
  convT((u16*)(ws + O_WZ), 2432, 1024, w_in, INW,
        [](int n) { return n < 544 ? n : (n < 1056 ? n + 256 : (n < ZW ? n + 512 : -1)); }, one);
  convT((u16*)(ws + O_WF), 512, 1024, w_in, INW, [](int n) { return n < 256 ? 544 + n : 1312 + (n - 256); }, one);
  convT((u16*)(ws + O_WG), 4096, 1024, w_in, INW, [](int n) { return 2848 + n; }, one);
  {
    const float* g = p.in[3] + l * 384;
    convT((u16*)(ws + O_WUQ), 384, 384, p.in[4] + (size_t)l * 384 * 384, 384, [](int n) { return n; },
          [g](int k) { return g[k]; });
  }
  {
    const float* g = p.in[5] + l * 128;
    const float* w = p.in[6] + (size_t)l * 128 * 512;
    convT((u16*)(ws + O_WKN), 256, 128, w, 512, [](int n) { return (n >> 6) * 128 + (n & 63); }, [g](int k) { return g[k]; });
    convT((u16*)(ws + O_WV), 256, 128, w, 512, [](int n) { return (n >> 6) * 128 + 64 + (n & 63); }, [g](int k) { return g[k]; });
  }
  const float* wb = p.in[18] + (size_t)l * 4 * 256 * 1024;
  convT((u16*)(ws + O_WB0), 1024, 256, wb, 1024, [](int n) { return n; }, one);
  convT((u16*)(ws + O_WB2), 1024, 256, wb + 2 * 256 * 1024, 1024, [](int n) { return n; }, one);
  convT((u16*)(ws + O_WB3), 1024, 256, wb + 3 * 256 * 1024, 1024, [](int n) { return n; }, one);
  convT((u16*)(ws + O_WO), 1024, 1024, p.in[19] + (size_t)l * 1024 * 1024, 1024, [](int n) { return n; }, one);
  convT((u16*)(ws + O_WGU), 5632, 1024, p.in[21] + (size_t)l * 1024 * 5632, 5632,
        [](int R) {
          const int tile = R >> 7, w = R & 127;
          const int col = tile * 64 + (w >> 6) * 32 + (w & 31);
          return ((w >> 5) & 1) ? DFF + col : col;
        },
        one);
  convT((u16*)(ws + O_WD), 1024, 2816, p.in[22] + (size_t)l * DFF * 1024, 1024, [](int n) { return n; }, one);
  {
    u16* dst = (u16*)(ws + O_WB1);
    const float* w1 = wb + 1 * 256 * 1024;
    for (int i = bidx() * 256 + tidx(); i < 1024 * 512; i += gridDim.x * 256) {
      const int j = i & 1023, kk = i >> 10;
      const int sel = kk >> 8, g = (kk >> 6) & 3, cc = kk & 63;
      float a = 0.f;
      for (int c2 = 0; c2 < 64; ++c2) {
        const float fr = (float)((cc * c2) & 63) * (1.f / 64.f);
        const float tr = sel ? -__builtin_amdgcn_sinf(fr) : __builtin_amdgcn_cosf(fr);
        a += tr * w1[(g * 64 + c2) * 1024 + j];
      }
      dst[j * 512 + kk] = f2bf(a * 0.125f);
    }
  }
  if (l == 0) {
    float* rc = (float*)(ws + O_RC);
    float* rs = (float*)(ws + O_RS);
    for (int i = bidx() * 256 + tidx(); i < 8192 * 16; i += gridDim.x * 256) {
      const int pos = i >> 4, fi = i & 15;
      const float invf = 1.0f / exp2f((float)fi * 0.8304820237218407f);
      const float ang = (float)pos * invf;
      double rv = (double)ang * 0.15915494309189535;
      rv -= floor(rv);
      const float fr = (float)rv;
      rc[i] = __builtin_amdgcn_cosf(fr);
      rs[i] = __builtin_amdgcn_sinf(fr);
    }
    u16* e1 = (u16*)(ws + O_E1);
    for (int i = bidx() * 256 + tidx(); i < 256 * 128; i += gridDim.x * 256) {
      const int R = i >> 7, s1 = i & 127;
      const int p1 = (R >> 7) * 64 + ((R >> 6) & 1) * 32 + (R & 31), ri = (R >> 5) & 1;
      const float fr = (float)((p1 * s1) & 127) * (1.f / 128.f);
      const float v = ri ? -__builtin_amdgcn_sinf(fr) : __builtin_amdgcn_cosf(fr);
      e1[i] = f2bf(v * 0.08838834764831845f);
    }
    u16* e2 = (u16*)(ws + O_E2);
    for (int i = bidx() * 256 + tidx(); i < 128 * 128; i += gridDim.x * 256) {
      const int R = i >> 7, kk = i & 127;
      const int sel = R >> 6, p2 = R & 63, s2 = kk >> 1, ri = kk & 1;
      const float fr = (float)((p2 * s2) & 63) * (1.f / 64.f);
      const float c = __builtin_amdgcn_cosf(fr), s = __builtin_amdgcn_sinf(fr);
      const float v = sel == 0 ? (ri == 0 ? c : s) : (ri == 0 ? s : -c);
      e2[i] = f2bf(v * 0.125f);
    }
  }
}

DI void ph_rmsnorm(const float* __restrict__ x, const float* __restrict__ g, u16* __restrict__ H) {
  const int lane = tidx() & 63, wave = tidx() >> 6;
  for (int row = bidx() * 4 + wave; row < T; row += gridDim.x * 4) {
    const float4* xr = (const float4*)(x + (size_t)row * 1024);
    float4 v[4];
    float ss = 0.f;
#pragma unroll
    for (int i = 0; i < 4; ++i) {
      v[i] = xr[lane + 64 * i];
      ss += v[i].x * v[i].x + v[i].y * v[i].y + v[i].z * v[i].z + v[i].w * v[i].w;
    }
#pragma unroll
    for (int o = 32; o >= 1; o >>= 1) ss += __shfl_xor(ss, o);
    const float r = rsqrtf(ss * (1.f / 1024.f) + EPS);
#pragma unroll
    for (int i = 0; i < 4; ++i) {
      const float4 gg = ((const float4*)g)[lane + 64 * i];
      uint2 o;
      o.x = pack2(v[i].x * r * gg.x, v[i].y * r * gg.y);
      o.y = pack2(v[i].z * r * gg.z, v[i].w * r * gg.w);
      *(uint2*)(H + (size_t)row * 1024 + (lane + 64 * i) * 4) = o;
    }
  }
}

DI void ph_inproj(const Params& p, u16* sm) {
  char* ws = p.ws;
  const u16* H = (const u16*)(ws + O_H);
  u16* Z = (u16*)(ws + O_Z);
  u16* UT = (u16*)(ws + O_UT);
  u16* VDT = (u16*)(ws + O_VDT);
  constexpr int NA = 256 * 19, NB = 4 * 256;
  for (int it = bidx(); it < NA + NB; it += gridDim.x) {
    f32x16 acc[2][2];
    zero_acc<2>(acc);
    if (it < NA) {
      const int tn = it % 19, tm = it / 19;
      gemm_ml<2>(H + (size_t)tm * 128 * 1024, 1024, (const u16*)(ws + O_WZ) + (size_t)tn * 128 * 1024, 1024, 1024, acc, sm);
      epi<2>(acc, [&](int m, int n, float v) {
        const int col = tn * 128 + n;
        if (col < ZW) Z[(size_t)(tm * 128 + m) * ZW + col] = f2bf(v);
      });
    } else {
      const int j = it - NA;
      const int tmf = j & 3, nt = j >> 2;
      const u16* A = (const u16*)(ws + O_WF) + (size_t)tmf * 128 * 1024;
      if (tmf < 2) {
        const int b = nt >> 6, s2 = nt & 63;
        gemm_ml<2>(A, 1024, H + ((size_t)b * 8192 + s2) * 1024, 64 * 1024, 1024, acc, sm);
        epi<2>(acc, [&](int m, int n, float v) {
          const int c = tmf * 128 + m;
          UT[(((size_t)b * 256 + c) * 64 + s2) * 128 + n] = f2bf(v);
        });
      } else {
        gemm_ml<2>(A, 1024, H + (size_t)nt * 128 * 1024, 1024, 1024, acc, sm);
        epi<2>(acc, [&](int m, int n, float v) {
          const int feat = (tmf - 2) * 128 + m;
          VDT[(size_t)feat * T + nt * 128 + n] = f2bf(v);
        });
      }
    }
  }
}

DI float hgrn_lb(const Params& p, int l, int dir, int ch) {
  if (l == 0) return 0.f;
  const float* lg = p.in[16] + dir * 2 * 256;
  const float x0 = lg[ch], x1 = lg[256 + ch];
  return 1.f / (1.f + expf(x0 - x1));
}

DI void hgrn_gates(const u16* zcol  , float lb, int dir, int w, int k, float* tot  ,
                   float (&cum)[16], float (&kk)[16], float& total) {
  float lf[16];
#pragma unroll
  for (int j = 0; j < 16; ++j) {
    const float z = bf2f(zcol[(size_t)(w * 16 + j) * ZW]);
    const float sg = 1.f / (1.f + expf(-z));
    const float f = lb + (1.f - lb) * sg;
    lf[j] = logf(f);
    kk[j] = 1.f - f;
  }
  float pre[16];
  float run = 0.f;
#pragma unroll
  for (int j = 0; j < 16; ++j) { run += lf[j]; pre[j] = run; }
  tot[w * 64 + k] = run;
  __syncthreads();
  const float t0 = tot[k], t1 = tot[64 + k], t2 = tot[128 + k], t3 = tot[192 + k];
  total = t0 + t1 + t2 + t3;
  float before = 0.f;
  if (w > 0) before += t0;
  if (w > 1) before += t1;
  if (w > 2) before += t2;
  const float after = total - before - run;
#pragma unroll
  for (int j = 0; j < 16; ++j) cum[j] = dir ? (after + run - pre[j] + lf[j]) : (before + pre[j]);
}

DI void hgrn_h1(const Params& p, int l, int item, u16* sm) {
  char* ws = p.ws;
  const u16* Z = (const u16*)(ws + O_Z);
  u16* ST = (u16*)(ws + O_ST);
  float* DEC = (float*)(ws + O_DEC);
  const int chunk = item & 127, dir = (item >> 7) & 1, h = (item >> 8) & 3, b = item >> 10;
  const int tid = tidx(), k = tid & 63, w = tid >> 6, lane = tid & 63, l31 = lane & 31, hh = lane >> 5;
  const size_t tok0 = (size_t)b * 8192 + chunk * 64;
  u16* KT = sm;
  u16* VT = sm + 64 * 72;
  float* tot = (float*)(sm + 2 * 64 * 72);
  float cum[16], kk[16], total;
  hgrn_gates(Z + tok0 * ZW + (dir ? 1824 : 1568) + h * 64 + k, hgrn_lb(p, l, dir, h * 64 + k), dir, w, k, tot, cum, kk, total);
  float kv[16], vv[16];
#pragma unroll
  for (int j = 0; j < 16; ++j) {
    kv[j] = kk[j] * expf(total - cum[j]);
    vv[j] = bf2f(Z[(tok0 + w * 16 + j) * ZW + 1312 + h * 64 + k]);
  }
  *(uint4*)(KT + k * 72 + w * 16) = pack8(kv);
  *(uint4*)(KT + k * 72 + w * 16 + 8) = pack8(kv + 8);
  *(uint4*)(VT + k * 72 + w * 16) = pack8(vv);
  *(uint4*)(VT + k * 72 + w * 16 + 8) = pack8(vv + 8);
  if (w == 0) DEC[(size_t)item * 64 + k] = expf(total);
  __syncthreads();
  const int mt = w >> 1, nt = w & 1;
  f32x16 acc;
#pragma unroll
  for (int r = 0; r < 16; ++r) acc[r] = 0.f;
#pragma unroll
  for (int ks = 0; ks < 4; ++ks) {
    const bf16x8 a = *(const bf16x8*)(VT + (mt * 32 + l31) * 72 + ks * 16 + hh * 8);
    const bf16x8 bq = *(const bf16x8*)(KT + (nt * 32 + l31) * 72 + ks * 16 + hh * 8);
    acc = MFMA(a, bq, acc);
  }
#pragma unroll
  for (int r = 0; r < 16; ++r) ST[(size_t)item * 4096 + (mt * 32 + crow(r, hh)) * 64 + nt * 32 + l31] = f2bf(acc[r]);
  __syncthreads();
}

DI void hgrn_h2(const Params& p) {
  char* ws = p.ws;
  u16* ST = (u16*)(ws + O_ST);
  const float* DEC = (const float*)(ws + O_DEC);
  for (int pi = bidx() * 256 + tidx(); pi < 32 * 2048; pi += gridDim.x * 256) {
    const int chain = pi >> 11, e2 = pi & 2047, dir = chain & 1;
    const int k = (2 * e2) & 63;
    float s0 = 0.f, s1 = 0.f;
#pragma unroll 8
    for (int c = 0; c < 128; ++c) {
      const int chunk = dir ? 127 - c : c;
      const size_t item = (size_t)chain * 128 + chunk;
      unsigned* ptr = (unsigned*)(ST + item * 4096 + 2 * e2);
      const unsigned u = *ptr;
      const float2 d = *(const float2*)(DEC + item * 64 + k);
      *ptr = pack2(s0, s1);
      s0 = d.x * s0 + bflo(u);
      s1 = d.y * s1 + bfhi(u);
    }
  }
}

DI void hgrn_h3(const Params& p, int l, int item, u16* sm) {
  char* ws = p.ws;
  const u16* Z = (const u16*)(ws + O_Z);
  const u16* ST = (const u16*)(ws + O_ST);
  u16* OH = (u16*)(ws + O_OH);
  const int chunk = item & 127, h = (item >> 7) & 3, b = item >> 9;
  const int tid = tidx(), k = tid & 63, w = tid >> 6, lane = tid & 63, l31 = lane & 31, hh = lane >> 5;
  const size_t tok0 = (size_t)b * 8192 + chunk * 64;
  u16* Q1 = sm;
  u16* Q2 = sm + 64 * 72;
  u16* KT = sm + 2 * 64 * 72;
  u16* VT = sm + 3 * 64 * 72;
  float* tot = (float*)(sm + 4 * 64 * 72);
  float* ssum = tot + 256;
  const int vt = w >> 1, tt = w & 1;
  {
    float vv[16];
#pragma unroll
    for (int j = 0; j < 16; ++j) vv[j] = bf2f(Z[(tok0 + w * 16 + j) * ZW + 1312 + h * 64 + k]);
    *(uint4*)(VT + k * 72 + w * 16) = pack8(vv);
    *(uint4*)(VT + k * 72 + w * 16 + 8) = pack8(vv + 8);
  }
  f32x16 O;
#pragma unroll
  for (int r = 0; r < 16; ++r) O[r] = 0.f;
  for (int dir = 0; dir < 2; ++dir) {
    float cum[16], kk[16], total;
    hgrn_gates(Z + tok0 * ZW + (dir ? 1824 : 1568) + h * 64 + k, hgrn_lb(p, l, dir, h * 64 + k), dir, w, k, tot, cum, kk, total);
    const float ref = 0.5f * total;
#pragma unroll
    for (int j = 0; j < 16; ++j) {
      const int t = w * 16 + j;
      const float q = bf2f(Z[(tok0 + t) * ZW + 1056 + h * 64 + k]);
      Q1[t * 72 + k] = f2bf(q * expf(cum[j] - ref));
      Q2[t * 72 + k] = f2bf(q * expf(cum[j]));
      KT[t * 72 + k] = f2bf(kk[j] * expf(ref - cum[j]));
    }
    __syncthreads();
    const size_t sti = ((size_t)((b * 4 + h) * 2 + dir) * 128 + chunk) * 4096;
#pragma unroll
    for (int sb = 0; sb < 2; ++sb) {
      f32x16 sc;
#pragma unroll
      for (int r = 0; r < 16; ++r) sc[r] = 0.f;
#pragma unroll
      for (int ks = 0; ks < 4; ++ks) {
        const bf16x8 a = *(const bf16x8*)(KT + (sb * 32 + l31) * 72 + ks * 16 + hh * 8);
        const bf16x8 bq = *(const bf16x8*)(Q1 + (tt * 32 + l31) * 72 + ks * 16 + hh * 8);
        sc = MFMA(a, bq, sc);
      }
      const int tcol = tt * 32 + l31;
      float pm[16];
#pragma unroll
      for (int r = 0; r < 16; ++r) {
        const int srow = sb * 32 + crow(r, hh);
        const bool keep = dir ? (srow >= tcol) : (srow <= tcol);
        pm[r] = keep ? sc[r] : 0.f;
      }
#pragma unroll
      for (int ts = 0; ts < 2; ++ts) {
        const uint4 pk = pack8(pm + 8 * ts);
        const bf16x8 pf = __builtin_bit_cast(bf16x8, pk);
        const u16* vp = VT + (vt * 32 + l31) * 72 + sb * 32 + ts * 16 + hh * 4;
        const s16x4 lo = *(const s16x4*)vp;
        const s16x4 hi = *(const s16x4*)(vp + 8);
        const bf16x8 vf = __builtin_shufflevector(lo, hi, 0, 1, 2, 3, 4, 5, 6, 7);
        O = MFMA(vf, pf, O);
      }
    }
#pragma unroll
    for (int ks = 0; ks < 4; ++ks) {
      const bf16x8 a = *(const bf16x8*)(ST + sti + (vt * 32 + l31) * 64 + ks * 16 + hh * 8);
      const bf16x8 bq = *(const bf16x8*)(Q2 + (tt * 32 + l31) * 72 + ks * 16 + hh * 8);
      O = MFMA(a, bq, O);
    }
    __syncthreads();
  }
  float ss = 0.f;
#pragma unroll
  for (int r = 0; r < 16; ++r) ss += O[r] * O[r];
  ss += __shfl_xor(ss, 32);
  if (hh == 0) ssum[vt * 64 + tt * 32 + l31] = ss;
  __syncthreads();
  const float rr = rsqrtf((ssum[tt * 32 + l31] + ssum[64 + tt * 32 + l31]) * (1.f / 64.f) + EPS);
  const size_t tok = tok0 + tt * 32 + l31;
  const float* gon = p.in[17] + l * 64;
#pragma unroll
  for (int i = 0; i < 4; ++i) {
    const int v0 = vt * 32 + 8 * i + 4 * hh;
    const uint2 hg = *(const uint2*)(Z + tok * ZW + 2080 + h * 64 + v0);
    const float g0 = 1.f / (1.f + expf(-bflo(hg.x))), g1 = 1.f / (1.f + expf(-bfhi(hg.x)));
    const float g2 = 1.f / (1.f + expf(-bflo(hg.y))), g3 = 1.f / (1.f + expf(-bfhi(hg.y)));
    uint2 o;
    o.x = pack2(O[4 * i + 0] * rr * gon[v0 + 0] * g0, O[4 * i + 1] * rr * gon[v0 + 1] * g1);
    o.y = pack2(O[4 * i + 2] * rr * gon[v0 + 2] * g2, O[4 * i + 3] * rr * gon[v0 + 3] * g3);
    *(uint2*)(OH + tok * 256 + h * 64 + v0) = o;
  }
  __syncthreads();
}

DI void prep_diff(const Params& p, int l, int blk) {
  char* ws = p.ws;
  const u16* Z = (const u16*)(ws + O_Z);
  const float* rc = (const float*)(ws + O_RC);
  const float* rs = (const float*)(ws + O_RS);
  for (int g = 0; g < 4; ++g) {
    const int isk = g >> 1;
    const int idx = tidx() + 256 * (g & 1);
    const int tl = idx >> 3, j = idx & 7;
    const int tok = blk * 64 + tl, b = tok >> 13, s = tok & 8191;
    const u16* src = Z + (size_t)tok * ZW + (isk ? 800 : 544) + j * 32;
    const float* gain = p.in[isk ? 10 : 9] + l * 32;
    float x[32];
#pragma unroll
    for (int i = 0; i < 4; ++i) unpack8(*(const uint4*)(src + 8 * i), x + 8 * i);
    float ss = 0.f;
#pragma unroll
    for (int i = 0; i < 32; ++i) ss += x[i] * x[i];
    const float r = rsqrtf(ss * (1.f / 32.f) + EPS);
#pragma unroll
    for (int i = 0; i < 32; ++i) x[i] = x[i] * r * gain[i];
    const float sc = isk ? 1.f : 0.17677669529663687f * LOG2E;
#pragma unroll
    for (int i = 0; i < 16; ++i) {
      const float c = rc[s * 16 + i], sn = rs[s * 16 + i];
      const float a = x[i], bb = x[i + 16];
      x[i] = (a * c - bb * sn) * sc;
      x[i + 16] = (a * sn + bb * c) * sc;
    }
    const int hd = j >> 1, mp = j & 1;
    u16* dst = (u16*)(ws + (isk ? O_KD : O_QD)) + ((((size_t)b * 4 + hd) * 2 + mp) * 8192 + s) * 32;
#pragma unroll
    for (int i = 0; i < 4; ++i) *(uint4*)(dst + 8 * i) = pack8(x + 8 * i);
  }
}

DI void prep_mla(const Params& p, int l, int blk) {
  char* ws = p.ws;
  const u16* Z = (const u16*)(ws + O_Z);
  const float* rc = (const float*)(ws + O_RC);
  const float* rs = (const float*)(ws + O_RS);
  const int tl = tidx() >> 2, hd = tidx() & 3;
  const int tok = blk * 64 + tl, b = tok >> 13, s = tok & 8191;
  for (int isk = 0; isk < 2; ++isk) {
    float x[96];
    if (!isk) {
      const u16* src = (const u16*)(ws + O_QRAW) + (size_t)tok * 384 + hd * 96;
#pragma unroll
      for (int i = 0; i < 12; ++i) unpack8(*(const uint4*)(src + 8 * i), x + 8 * i);
    } else {
      const u16* src = (const u16*)(ws + O_KN) + (size_t)tok * 256 + hd * 64;
#pragma unroll
      for (int i = 0; i < 8; ++i) unpack8(*(const uint4*)(src + 8 * i), x + 8 * i);
      const u16* src2 = Z + (size_t)tok * ZW + 512;
#pragma unroll
      for (int i = 0; i < 4; ++i) unpack8(*(const uint4*)(src2 + 8 * i), x + 64 + 8 * i);
    }
    const float* gain = p.in[isk ? 8 : 7] + l * 96;
    float ss = 0.f;
#pragma unroll
    for (int i = 0; i < 96; ++i) ss += x[i] * x[i];
    const float r = rsqrtf(ss * (1.f / 96.f) + EPS);
#pragma unroll
    for (int i = 0; i < 96; ++i) x[i] = x[i] * r * gain[i];
    const float sc = isk ? 1.f : 0.10206207261596575f * LOG2E;
#pragma unroll
    for (int i = 0; i < 64; ++i) x[i] *= sc;
#pragma unroll
    for (int i = 0; i < 16; ++i) {
      const float c = rc[s * 16 + i], sn = rs[s * 16 + i];
      const float a = x[64 + i], bb = x[80 + i];
      x[64 + i] = (a * c - bb * sn) * sc;
      x[80 + i] = (a * sn + bb * c) * sc;
    }
    u16* dst = (u16*)(ws + (isk ? O_KM : O_QM)) + (((size_t)b * 4 + hd) * 8192 + s) * 96;
#pragma unroll
    for (int i = 0; i < 12; ++i) *(uint4*)(dst + 8 * i) = pack8(x + 8 * i);
  }
}

#define SEG_LOOP(it, base, n) \
  _Pragma("unroll 1") for (int it = (int)((bidx() + gridDim.x - ((base) % gridDim.x)) % gridDim.x); it < (n); it += gridDim.x)

DI void ph_c(const Params& p, int l, u16* sm) {
  char* ws = p.ws;
  const u16* Z = (const u16*)(ws + O_Z);
  float* rstd = (float*)((char*)sm + 73728);
  SEG_LOOP(it, 0, 768) {
    const int tn = it % 3, tm = it / 3;
    f32x16 acc[2][2]; zero_acc<2>(acc);
    const u16* A = Z + (size_t)tm * 128 * ZW;
    block_rstd(A, ZW, 384, rstd);
    gemm_ml<2, 1>(A, ZW, (const u16*)(ws + O_WUQ) + (size_t)tn * 128 * 384, 384, 384, acc, sm);
    u16* dst = (u16*)(ws + O_QRAW);
    epi<2>(acc, [&](int m, int n, float v) { dst[(size_t)(tm * 128 + m) * 384 + tn * 128 + n] = f2bf(v * rstd[m]); });
    __syncthreads();
  }
  SEG_LOOP(it, 768, 512) {
    const int tn = it & 1, tm = it >> 1;
    f32x16 acc[2][2]; zero_acc<2>(acc);
    const u16* A = Z + (size_t)tm * 128 * ZW + 384;
    block_rstd(A, ZW, 128, rstd);
    gemm_ml<2, 1>(A, ZW, (const u16*)(ws + O_WKN) + (size_t)tn * 128 * 128, 128, 128, acc, sm);
    u16* dst = (u16*)(ws + O_KN);
    epi<2>(acc, [&](int m, int n, float v) { dst[(size_t)(tm * 128 + m) * 256 + tn * 128 + n] = f2bf(v * rstd[m]); });
    __syncthreads();
  }
  SEG_LOOP(it, 1280, 512) {
    const int tmf = it & 1, nt = it >> 1;
    f32x16 acc[2][2]; zero_acc<2>(acc);
    const u16* B = Z + (size_t)nt * 128 * ZW + 384;
    block_rstd(B, ZW, 128, rstd);
    gemm_ml<2, 1>((const u16*)(ws + O_WV) + (size_t)tmf * 128 * 128, 128, B, ZW, 128, acc, sm);
    u16* dst = (u16*)(ws + O_VMT);
    epi<2>(acc, [&](int m, int n, float v) { dst[(size_t)(tmf * 128 + m) * T + nt * 128 + n] = f2bf(v * rstd[n]); });
    __syncthreads();
  }
  SEG_LOOP(it, 1792, 1024) {
    const int tmE = it & 1, tn = it >> 1;
    f32x16 acc[2][2]; zero_acc<2>(acc);
    gemm_ml<2, 1>((const u16*)(ws + O_E1) + (size_t)tmE * 128 * 128, 128, (const u16*)(ws + O_UT) + (size_t)tn * 128 * 128, 128, 128, acc, sm);
    u16* GT = (u16*)(ws + O_GT);
    const int lane = tidx() & 63, wave = tidx() >> 6, l31 = lane & 31, hh = lane >> 5, wm = wave >> 1, wn = wave & 1;
#pragma unroll
    for (int nt = 0; nt < 2; ++nt)
#pragma unroll
      for (int r = 0; r < 16; ++r) {
        const float re = acc[0][nt][r], im = acc[1][nt][r];
        const int p1 = tmE * 64 + wm * 32 + crow(r, hh);
        const int n = tn * 128 + wn * 64 + nt * 32 + l31;
        const int b = n >> 14, c = (n >> 6) & 255, s2 = n & 63;
        const float fr = (float)(s2 * p1) * (1.f / 8192.f);
        const float cs = __builtin_amdgcn_cosf(fr), sn = __builtin_amdgcn_sinf(fr);
        const float re2 = re * cs + im * sn, im2 = im * cs - re * sn;
        *(unsigned*)(GT + ((((size_t)(b * 128 + p1)) * 256 + c) * 64 + s2) * 2) = pack2(re2, im2);
      }
  }
  SEG_LOOP(it, 2816, 512) { prep_diff(p, l, it); }
  SEG_LOOP(it, 3328, 4096) { hgrn_h1(p, l, it, sm); }
}

DI void ph_d(const Params& p, int l, u16* sm) {
  char* ws = p.ws;
  SEG_LOOP(tn, 0, 1024) {
    f32x16 acc[2][2]; zero_acc<2>(acc);
    gemm_ml<2, 1>((const u16*)(ws + O_E2), 128, (const u16*)(ws + O_GT) + (size_t)tn * 128 * 128, 128, 128, acc, sm);
    u16* OF = (u16*)(ws + O_OF);
    epi<2>(acc, [&](int m, int n, float v) {
      const int sel = m >> 6, p2 = m & 63;
      const int nn = tn * 128 + n;
      const int b = nn >> 15, p1 = (nn >> 8) & 127, c = nn & 255;
      const size_t tok = (size_t)b * 8192 + p1 + 128 * p2;
      OF[tok * 512 + sel * 256 + c] = f2bf(v);
    });
  }
  SEG_LOOP(it, 1024, 512) { prep_mla(p, l, it); }
  hgrn_h2(p);
}

template <int DK, int NMAP, int PF>
DI void attn_core(const u16* __restrict__ Qb, const u16* __restrict__ Kb, long mapstride, const u16* __restrict__ VTb, int q0,
                  f32x16 (&O)[NMAP][2], float (&ls)[NMAP], u16* sm) {
  constexpr int KS = DK / 16, KROW = DK + 8, KT_E = NMAP * 64 * KROW, VROW = 68, BUF = KT_E + 64 * VROW;
  constexpr int KCH = 64 * DK / 8 / 256;
  constexpr int CPR = DK / 8;
  const int tid = tidx(), lane = tid & 63, wave = tid >> 6, l31 = lane & 31, hh = lane >> 5;
  bf16x8 qf[NMAP][KS];
  {
    const int query = q0 + wave * 32 + l31;
#pragma unroll
    for (int mp = 0; mp < NMAP; ++mp)
#pragma unroll
      for (int ks = 0; ks < KS; ++ks) qf[mp][ks] = *(const bf16x8*)(Qb + mp * mapstride + (long)query * DK + ks * 16 + hh * 8);
  }
#pragma unroll
  for (int mp = 0; mp < NMAP; ++mp) {
    ls[mp] = 0.f;
#pragma unroll
    for (int dt = 0; dt < 2; ++dt)
#pragma unroll
      for (int r = 0; r < 16; ++r) O[mp][dt][r] = 0.f;
  }
  constexpr int NK = NMAP * KCH;
  struct Stg { u32x4 k0, k1, k2, v0, v1; };
  Stg r0, r1;
  const u16* gk0 = Kb + (0 / KCH) * mapstride + (tid + 256 * (0 % KCH)) * 8;
  const u16* gk1 = Kb + (1 / KCH) * mapstride + (tid + 256 * (1 % KCH)) * 8;
  const u16* gk2 = Kb + ((NK > 2 ? 2 : 0) / KCH) * mapstride + (tid + 256 * ((NK > 2 ? 2 : 0) % KCH)) * 8;
  const int c0 = tid + 256 * (0 % KCH), c1 = tid + 256 * (1 % KCH), c2 = tid + 256 * ((NK > 2 ? 2 : 0) % KCH);
  const int lk0 = ((0 / KCH) * 64 + c0 / CPR) * KROW + (c0 % CPR) * 8;
  const int lk1 = ((1 / KCH) * 64 + c1 / CPR) * KROW + (c1 % CPR) * 8;
  const int lk2 = (((NK > 2 ? 2 : 0) / KCH) * 64 + c2 / CPR) * KROW + (c2 % CPR) * 8;
  const u16* gv0 = VTb + (long)(tid >> 3) * T + (tid & 7) * 8;
  const u16* gv1 = VTb + (long)((tid + 256) >> 3) * T + (tid & 7) * 8;
  const int lv0 = (tid >> 3) * VROW + (tid & 7) * 8;
  const int lv1 = ((tid + 256) >> 3) * VROW + (tid & 7) * 8;
#define AGL(R, kt_)                                              \
  {                                                              \
    const long ko = (long)(kt_) * 64 * DK;                       \
    R.k0 = *(const u32x4*)(gk0 + ko);                            \
    R.k1 = *(const u32x4*)(gk1 + ko);                            \
    if (NK > 2) R.k2 = *(const u32x4*)(gk2 + ko);                \
    R.v0 = *(const u32x4*)(gv0 + (kt_) * 64);                    \
    R.v1 = *(const u32x4*)(gv1 + (kt_) * 64);                    \
  }
#define ASW(R, buf_)                                             \
  {                                                              \
    u16* ks_ = sm + (buf_) * BUF;                                \
    u16* vs_ = ks_ + KT_E;                                       \
    *(u32x4*)(ks_ + lk0) = R.k0;                                 \
    *(u32x4*)(ks_ + lk1) = R.k1;                                 \
    if (NK > 2) *(u32x4*)(ks_ + lk2) = R.k2;                     \
    *(uint2*)(vs_ + lv0) = make_uint2(R.v0[0], R.v0[1]);         \
    *(uint2*)(vs_ + lv0 + 4) = make_uint2(R.v0[2], R.v0[3]);     \
    *(uint2*)(vs_ + lv1) = make_uint2(R.v1[0], R.v1[1]);         \
    *(uint2*)(vs_ + lv1 + 4) = make_uint2(R.v1[2], R.v1[3]);     \
  }
  auto compute = [&](int buf) {
    const u16* ks_ = sm + buf * BUF;
    const u16* vs_ = ks_ + KT_E;
#pragma unroll
    for (int sb = 0; sb < 2; ++sb) {
      bf16x8 pf[NMAP][2];
#pragma unroll
      for (int mp = 0; mp < NMAP; ++mp) {
        f32x16 s;
#pragma unroll
        for (int r = 0; r < 16; ++r) s[r] = 0.f;
#pragma unroll
        for (int ks = 0; ks < KS; ++ks) {
          const bf16x8 kf = *(const bf16x8*)(ks_ + (mp * 64 + sb * 32 + l31) * KROW + ks * 16 + hh * 8);
          s = MFMA(kf, qf[mp][ks], s);
        }
        float pr[16];
        float a0 = 0.f, a1 = 0.f, a2 = 0.f, a3 = 0.f;
#pragma unroll
        for (int r = 0; r < 16; r += 4) {
          pr[r] = __builtin_amdgcn_exp2f(s[r]); a0 += pr[r];
          pr[r + 1] = __builtin_amdgcn_exp2f(s[r + 1]); a1 += pr[r + 1];
          pr[r + 2] = __builtin_amdgcn_exp2f(s[r + 2]); a2 += pr[r + 2];
          pr[r + 3] = __builtin_amdgcn_exp2f(s[r + 3]); a3 += pr[r + 3];
        }
        ls[mp] += (a0 + a1) + (a2 + a3);
        pf[mp][0] = __builtin_bit_cast(bf16x8, pack8(pr));
        pf[mp][1] = __builtin_bit_cast(bf16x8, pack8(pr + 8));
      }
#pragma unroll
      for (int ts = 0; ts < 2; ++ts)
#pragma unroll
        for (int dt = 0; dt < 2; ++dt) {
          const u16* vp = vs_ + (dt * 32 + l31) * VROW + sb * 32 + ts * 16 + hh * 4;
          const s16x4 lo = *(const s16x4*)vp;
          const s16x4 hi = *(const s16x4*)(vp + 8);
          const bf16x8 vf = __builtin_shufflevector(lo, hi, 0, 1, 2, 3, 4, 5, 6, 7);
#pragma unroll
          for (int mp = 0; mp < NMAP; ++mp) O[mp][dt] = MFMA(vf, pf[mp][ts], O[mp][dt]);
        }
    }
  };
  constexpr int NKT = SEQ / 64;
  if (PF == 2) {
    AGL(r0, 0);
    AGL(r1, 1);
    ASW(r0, 0);
    __syncthreads();
#pragma unroll 1
    for (int kt = 0; kt < NKT; kt += 2) {
      if (kt + 2 < NKT) AGL(r0, kt + 2);
      compute(0);
      ASW(r1, 1);
      __syncthreads();
      if (kt + 3 < NKT) AGL(r1, kt + 3);
      compute(1);
      if (kt + 2 < NKT) ASW(r0, 0);
      __syncthreads();
    }
  } else {
    AGL(r0, 0);
    ASW(r0, 0);
    __syncthreads();
#pragma unroll 1
    for (int kt = 0; kt < NKT; ++kt) {
      const int buf = kt & 1;
      if (kt + 1 < NKT) AGL(r0, kt + 1);
      compute(buf);
      if (kt + 1 < NKT) ASW(r0, buf ^ 1);
      __syncthreads();
    }
  }
#undef AGL
#undef ASW
#pragma unroll
  for (int mp = 0; mp < NMAP; ++mp) ls[mp] += __shfl_xor(ls[mp], 32);
}

DI void attn_mla(const Params& p, int l, int id, u16* sm) {
  char* ws = p.ws;
  const int lane = tidx() & 63, wave = tidx() >> 6, l31 = lane & 31, hh = lane >> 5;
  const int bh = id >> 6, qb = id & 63, b = bh >> 2, hd = bh & 3;
  const int q0 = qb * 128;
  const size_t tok = (size_t)b * 8192 + q0 + wave * 32 + l31;
  f32x16 O[1][2];
  float ls[1];
  attn_core<96, 1, 2>((const u16*)(ws + O_QM) + (size_t)bh * 8192 * 96, (const u16*)(ws + O_KM) + (size_t)bh * 8192 * 96, 0,
                   (const u16*)(ws + O_VMT) + (size_t)(hd * 64) * T + (size_t)b * 8192, q0, O, ls, sm);
  const float inv = 1.f / ls[0];
  u16* dst = (u16*)(ws + O_OM) + tok * 256 + hd * 64;
#pragma unroll
  for (int dt = 0; dt < 2; ++dt)
#pragma unroll
    for (int i = 0; i < 4; ++i) {
      uint2 o;
      o.x = pack2(O[0][dt][4 * i] * inv, O[0][dt][4 * i + 1] * inv);
      o.y = pack2(O[0][dt][4 * i + 2] * inv, O[0][dt][4 * i + 3] * inv);
      *(uint2*)(dst + dt * 32 + 8 * i + 4 * hh) = o;
    }
}

DI void attn_diff(const Params& p, int l, int id, u16* sm) {
  char* ws = p.ws;
  const int lane = tidx() & 63, wave = tidx() >> 6, l31 = lane & 31, hh = lane >> 5;
  const int bh = id >> 6, qb = id & 63, b = bh >> 2, hd = bh & 3;
  const int q0 = qb * 128;
  const size_t tok = (size_t)b * 8192 + q0 + wave * 32 + l31;
  f32x16 O[2][2];
  float ls[2];
  attn_core<32, 2, 1>((const u16*)(ws + O_QD) + (size_t)bh * 2 * 8192 * 32, (const u16*)(ws + O_KD) + (size_t)bh * 2 * 8192 * 32,
                   8192 * 32, (const u16*)(ws + O_VDT) + (size_t)(hd * 64) * T + (size_t)b * 8192, q0, O, ls, sm);
  float d1 = 0.f, d2 = 0.f;
  for (int i = 0; i < 32; ++i) {
    d1 += p.in[11][l * 32 + i] * p.in[12][l * 32 + i];
    d2 += p.in[13][l * 32 + i] * p.in[14][l * 32 + i];
  }
  const float lam_init = 0.8f - 0.6f * expf(-0.3f * (float)l);
  const float lam = expf(d1) - expf(d2) + lam_init;
  const float i1 = 1.f / ls[0], i2 = lam / ls[1];
  float ss = 0.f;
#pragma unroll
  for (int dt = 0; dt < 2; ++dt)
#pragma unroll
    for (int r = 0; r < 16; ++r) {
      const float v = O[0][dt][r] * i1 - O[1][dt][r] * i2;
      O[0][dt][r] = v;
      ss += v * v;
    }
  ss += __shfl_xor(ss, 32);
  const float rr = rsqrtf(ss * (1.f / 64.f) + EPS) * (1.f - lam_init);
  const float* gs = p.in[15] + l * 64;
  u16* dst = (u16*)(ws + O_OD) + tok * 256 + hd * 64;
#pragma unroll
  for (int dt = 0; dt < 2; ++dt)
#pragma unroll
    for (int i = 0; i < 4; ++i) {
      const int d0 = dt * 32 + 8 * i + 4 * hh;
      uint2 o;
      o.x = pack2(O[0][dt][4 * i] * rr * gs[d0], O[0][dt][4 * i + 1] * rr * gs[d0 + 1]);
      o.y = pack2(O[0][dt][4 * i + 2] * rr * gs[d0 + 2], O[0][dt][4 * i + 3] * rr * gs[d0 + 3]);
      *(uint2*)(dst + d0) = o;
    }
}

DI void ph_e(const Params& p, int l, u16* sm) {
#ifndef NO_MLA
  SEG_LOOP(it, 0, 1024) {
    const int xcd = it & 7, q = it >> 3, grp = q >> 6, j = q & 63;
    attn_mla(p, l, (grp * 8 + xcd) * 64 + j, sm);
  }
#endif
#ifndef NO_DIFF
  SEG_LOOP(it, 1024, 1024) {
    const int xcd = it & 7, q = it >> 3, grp = q >> 6, j = q & 63;
    attn_diff(p, l, (grp * 8 + xcd) * 64 + j, sm);
  }
#endif
#ifndef NO_H3
  SEG_LOOP(it, 2048, 2048) { hgrn_h3(p, l, it, sm); }
#endif
}

DI void ph_merge(const Params& p, u16* sm) {
  char* ws = p.ws;
  const u16* H = (const u16*)(ws + O_H);
  u16* MG = (u16*)(ws + O_MG);
#pragma unroll 1
  for (int it = bidx(); it < 256 * 8; it += gridDim.x) {
    const int tn = it & 7, tm = it >> 3;
    unsigned mgp[2][2][8];
#pragma unroll
    for (int mt = 0; mt < 2; ++mt)
#pragma unroll
      for (int nt = 0; nt < 2; ++nt)
#pragma unroll
        for (int r = 0; r < 8; ++r) mgp[mt][nt][r] = 0u;
#pragma unroll 1
    for (int n = 0; n < 4; ++n) {
      unsigned gp[2][2][8];
      {
        f32x16 ag[2][2];
        zero_acc<2>(ag);
        gemm_ml<2, 2>(H + (size_t)tm * 128 * 1024, 1024, (const u16*)(ws + O_WG) + ((size_t)n * 1024 + tn * 128) * 1024, 1024, 1024, ag, sm);
#pragma unroll
        for (int mt = 0; mt < 2; ++mt)
#pragma unroll
          for (int nt = 0; nt < 2; ++nt)
#pragma unroll
            for (int r = 0; r < 8; ++r) gp[mt][nt][r] = pack2(sigmoid_fast(ag[mt][nt][2 * r]), sigmoid_fast(ag[mt][nt][2 * r + 1]));
      }
      f32x16 ab[2][2];
      zero_acc<2>(ab);
      const size_t oa = n == 0 ? O_OM : (n == 1 ? O_OF : (n == 2 ? O_OD : O_OH));
      const size_t ob = n == 0 ? O_WB0 : (n == 1 ? O_WB1 : (n == 2 ? O_WB2 : O_WB3));
      const int kn = n == 1 ? 512 : 256;
      gemm_ml<2, 1>((const u16*)(ws + oa) + (size_t)tm * 128 * kn, kn, (const u16*)(ws + ob) + (size_t)tn * 128 * kn, kn, kn, ab, sm);
#pragma unroll
      for (int mt = 0; mt < 2; ++mt)
#pragma unroll
        for (int nt = 0; nt < 2; ++nt)
#pragma unroll
          for (int r = 0; r < 8; ++r) {
            const float m0 = bflo(mgp[mt][nt][r]) + bflo(gp[mt][nt][r]) * ab[mt][nt][2 * r];
            const float m1 = bfhi(mgp[mt][nt][r]) + bfhi(gp[mt][nt][r]) * ab[mt][nt][2 * r + 1];
            mgp[mt][nt][r] = pack2(m0, m1);
          }
    }
    {
      const int lane = tidx() & 63, wave = tidx() >> 6, l31 = lane & 31, hh = lane >> 5, wm = wave >> 1, wn = wave & 1;
#pragma unroll
      for (int mt = 0; mt < 2; ++mt)
#pragma unroll
        for (int nt = 0; nt < 2; ++nt)
#pragma unroll
          for (int r = 0; r < 8; ++r) {
            const size_t row = (size_t)(tm * 128 + wm * 64 + mt * 32 + crow(2 * r, hh));
            const int col = tn * 128 + wn * 64 + nt * 32 + l31;
            MG[row * 1024 + col] = (u16)(mgp[mt][nt][r] & 0xffffu);
            MG[(row + 1) * 1024 + col] = (u16)(mgp[mt][nt][r] >> 16);
          }
    }
  }
}

DI void ph_resid_gemm(const u16* A, int K, const u16* W, const float* xin, float* xout, u16* sm) {
  for (int it = bidx(); it < 256 * 8; it += gridDim.x) {
    const int tn = it & 7, tm = it >> 3;
    f32x16 acc[2][2];
    zero_acc<2>(acc);
    gemm_ml<2>(A + (size_t)tm * 128 * K, K, W + (size_t)tn * 128 * K, K, K, acc, sm);
    epi<2>(acc, [&](int m, int n, float v) {
      const size_t o = (size_t)(tm * 128 + m) * 1024 + tn * 128 + n;
      xout[o] = xin[o] + v;
    });
  }
}

DI void ph_gateup(const Params& p, u16* sm) {
  char* ws = p.ws;
  const u16* H = (const u16*)(ws + O_H);
  u16* ACT = (u16*)(ws + O_ACT);
  const int lane = tidx() & 63, wave = tidx() >> 6, l31 = lane & 31, hh = lane >> 5, wm = wave >> 1, wn = wave & 1;
  for (int it = bidx(); it < 256 * 44; it += gridDim.x) {
    const int tn = it % 44, tm = it / 44;
    f32x16 acc[2][2];
    zero_acc<2>(acc);
    gemm_ml<2>(H + (size_t)tm * 128 * 1024, 1024, (const u16*)(ws + O_WGU) + (size_t)tn * 128 * 1024, 1024, 1024, acc, sm);
#pragma unroll
    for (int mt = 0; mt < 2; ++mt)
#pragma unroll
      for (int r = 0; r < 16; ++r) {
        const float g = acc[mt][0][r], u = acc[mt][1][r];
        const float a = g * sigmoid_fast(g) * u;
        ACT[(size_t)(tm * 128 + wm * 64 + mt * 32 + crow(r, hh)) * DFF + tn * 64 + wn * 32 + l31] = f2bf(a);
      }
  }
}

constexpr int NPH = 10;
#ifndef LB_MIN
#define LB_MIN 2
#endif

template <bool COOP>
__global__ void __launch_bounds__(256, LB_MIN) mk(Params p, int ph_lo, int ph_hi) {
  __shared__ __attribute__((aligned(16))) u16 sm[SMEM_BYTES / 2];
  char* ws = p.ws;
#ifndef PROBE_MASK
#define PROBE_MASK 0
#endif
  int rr = 0;
  (void)rr;
  for (int ph = ph_lo; ph < ph_hi; ++ph) {
    const int l = ph / NPH, s = ph % NPH;
    const float* xin = l == 0 ? p.in[0] : p.out;
#ifndef ONLY_PHASE
#define ONLY_PHASE -1
#endif
#define PH_ON(x) (ONLY_PHASE < 0 || ONLY_PHASE == (x))
    switch (s) {
      case 0:
        if (!PH_ON(0)) break;
        ph_wprep(p, l);
        ph_rmsnorm(xin, p.in[1] + l * 1024, (u16*)(ws + O_H));
        break;
      case 1: if (PH_ON(1)) ph_inproj(p, sm); break;
      case 2: if (PH_ON(2)) ph_c(p, l, sm); break;
      case 3: if (PH_ON(3)) ph_d(p, l, sm); break;
      case 4: if (PH_ON(4)) ph_e(p, l, sm); break;
      case 5: if (PH_ON(5)) ph_merge(p, sm); break;
      case 6: if (PH_ON(6)) ph_resid_gemm((const u16*)(ws + O_MG), 1024, (const u16*)(ws + O_WO), xin, p.out, sm); break;
      case 7: if (PH_ON(7)) ph_rmsnorm(p.out, p.in[20] + l * 1024, (u16*)(ws + O_H)); break;
      case 8: if (PH_ON(8)) ph_gateup(p, sm); break;
      case 9: if (PH_ON(9)) ph_resid_gemm((const u16*)(ws + O_ACT), DFF, (const u16*)(ws + O_WD), p.out, p.out, sm); break;
    }
    if (COOP) {
      if (ph + 1 < ph_hi) cg::this_grid().sync();
    }
#if PROBE_MASK
    if (COOP && rr == 0 && ph < NPH && ((PROBE_MASK >> ph) & 1)) { rr = 1; --ph; } else rr = 0;
#endif
  }
}

extern "C" void kernel_launch(void* const* d_in, const int* in_sizes, int n_in, void* d_out, int out_size, void* d_ws,
                              size_t ws_size, hipStream_t stream) {
  Params p{};
  for (int i = 0; i < 23; ++i) p.in[i] = (const float*)d_in[i];
  p.out = (float*)d_out;
  p.ws = (char*)d_ws;
  if (ws_size < O_END) fprintf(stderr, "workspace too small: %zu < %zu\n", ws_size, (size_t)O_END);
  static int grid_blocks = 0;
  if (!grid_blocks) {
    int dev = 0, cus = 0, per_cu = 0;
    hipGetDevice(&dev);
    hipDeviceGetAttribute(&cus, hipDeviceAttributeMultiprocessorCount, dev);
#if MK_ONE_LAUNCH
    hipOccupancyMaxActiveBlocksPerMultiprocessor(&per_cu, mk<true>, 256, 0);
#else
    hipOccupancyMaxActiveBlocksPerMultiprocessor(&per_cu, mk<false>, 256, 0);
#endif
    if (per_cu < 1) per_cu = 1;
    if (per_cu > 2) per_cu = 2;
    grid_blocks = cus * per_cu;
  }
#if MK_ONE_LAUNCH
  int lo = 0, hi = 2 * NPH;
  void* args[] = {&p, &lo, &hi};
  hipError_t e = hipLaunchCooperativeKernel((void*)mk<true>, dim3(grid_blocks), dim3(256), args, 0, stream);
  if (e != hipSuccess) fprintf(stderr, "cooperative launch failed: %s (grid %d)\n", hipGetErrorString(e), grid_blocks);
#else
  for (int ph = 0; ph < 2 * NPH; ++ph) mk<false><<<grid_blocks, 256, 0, stream>>>(p, ph, ph + 1);
#endif
}
```

```cpp
#include <hip/hip_runtime.h>
#include <hip/hip_cooperative_groups.h>
#include <cstdio>
namespace cg = cooperative_groups;

#ifndef MK_ONE_LAUNCH
#define MK_ONE_LAUNCH 1
#endif

#define DI __device__ __forceinline__
typedef unsigned short u16;
typedef __bf16 bf2_t __attribute__((ext_vector_type(2)));
typedef float f2_t __attribute__((ext_vector_type(2)));
using bf16x8 = __attribute__((ext_vector_type(8))) short;
using s16x4 = __attribute__((ext_vector_type(4))) short;
using f32x16 = __attribute__((ext_vector_type(16))) float;
using u32x4 = __attribute__((ext_vector_type(4))) unsigned;
using f32x4_t = __attribute__((ext_vector_type(4))) float;
#define MFMA(a, b, c) __builtin_amdgcn_mfma_f32_32x32x16_bf16((a), (b), (c), 0, 0, 0)

constexpr int T = 32768, SEQ = 8192, ZW = 2336, INW = 6944, DFF = 2816;
constexpr float EPS = 1e-6f;
constexpr float LOG2E = 1.4426950408889634f;

constexpr size_t O_WZ = 0;
constexpr size_t O_WF = O_WZ + 2560ull * 1024 * 2;
constexpr size_t O_WG = O_WF + 512ull * 1024 * 2;
constexpr size_t O_WUQ = O_WG + 4096ull * 1024 * 2;
constexpr size_t O_WKN = O_WUQ + 384ull * 384 * 2;
constexpr size_t O_WV = O_WKN + 256ull * 128 * 2;
constexpr size_t O_WB0 = O_WV + 256ull * 128 * 2;
constexpr size_t O_WB1 = O_WB0 + 1024ull * 256 * 2;
constexpr size_t O_WB2 = O_WB1 + 1024ull * 512 * 2;
constexpr size_t O_WB3 = O_WB2 + 1024ull * 256 * 2;
constexpr size_t O_WO = O_WB3 + 1024ull * 256 * 2;
constexpr size_t O_WGU = O_WO + 1024ull * 1024 * 2;
constexpr size_t O_WD = O_WGU + 5632ull * 1024 * 2;
constexpr size_t O_RC = O_WD + 1024ull * 2816 * 2;
constexpr size_t O_RS = O_RC + 8192ull * 16 * 4;
constexpr size_t O_E1 = O_RS + 8192ull * 16 * 4;
constexpr size_t O_E2 = O_E1 + 256ull * 128 * 2;
constexpr size_t O_H = O_E2 + 128ull * 128 * 2;
constexpr size_t O_OF = O_H + (size_t)T * 1024 * 2;
constexpr size_t O_Z = O_OF + (size_t)T * 512 * 2;
constexpr size_t O_UT = O_Z + (size_t)T * ZW * 2;
constexpr size_t O_QM = O_UT;
constexpr size_t O_VDT = O_UT + (size_t)T * 384 * 2;
constexpr size_t O_VMT = O_VDT + (size_t)T * 256 * 2;
constexpr size_t O_KM = O_VMT + (size_t)T * 256 * 2;
constexpr size_t O_QD = O_KM + (size_t)T * 384 * 2;
constexpr size_t O_KD = O_QD + (size_t)T * 256 * 2;
constexpr size_t O_ST = O_KD + (size_t)T * 256 * 2;
constexpr size_t O_DEC = O_ST + 4096ull * 4096 * 2;
constexpr size_t O_GT = O_DEC + 4096ull * 64 * 4;
constexpr size_t O_OH = O_GT;
constexpr size_t O_QRAW = O_GT + (size_t)T * 512 * 2;
constexpr size_t O_OM = O_QRAW;
constexpr size_t O_KN = O_QRAW + (size_t)T * 384 * 2;
constexpr size_t O_OD = O_KN;
constexpr size_t O_END = O_KN + (size_t)T * 256 * 2;
constexpr size_t O_BAR = O_END;
constexpr size_t O_END2 = O_BAR + 16384;
constexpr size_t O_G = O_Z;
static_assert(O_G + (size_t)T * 4096 * 2 <= O_ST, "gate buffer overlaps live data");
constexpr size_t O_MG = O_H;
constexpr size_t O_ACT = O_Z;

constexpr int SMEM_BYTES = 73728 + 1024;

struct Params {
  const float* in[23];
  float* out;
  char* ws;
};

DI int tidx() { int t = threadIdx.x & 255; asm volatile("" : "+v"(t)); return t; }
DI int bidx() { int t = __builtin_amdgcn_readfirstlane((int)(blockIdx.x * 2 + (threadIdx.x >> 8))); asm volatile("" : "+s"(t)); return t; }
#define VGRID ((int)gridDim.x * 2)
DI char* lws(char* w) { unsigned long long x = (unsigned long long)w; asm volatile("" : "+s"(x)); return (char*)x; }
DI int rtid() { int t = threadIdx.x; asm volatile("" : "+v"(t)); return t; }
DI int rbid() { int t = blockIdx.x; asm volatile("" : "+s"(t)); return t; }
DI float bf2f(u16 v) { return __uint_as_float(((unsigned)v) << 16); }
DI float bflo(unsigned v) { return __uint_as_float(v << 16); }
DI float bfhi(unsigned v) { return __uint_as_float(v & 0xffff0000u); }
DI unsigned pack2(float a, float b) {
  f2_t v = {a, b};
  return __builtin_bit_cast(unsigned, __builtin_convertvector(v, bf2_t));
}
DI u16 f2bf(float a) { return (u16)(pack2(a, 0.f) & 0xffffu); }
DI float sigmoid_fast(float x) { return __builtin_amdgcn_rcpf(1.f + __expf(-x)); }
DI int crow(int r, int hh) { return (r & 3) + 8 * (r >> 2) + 4 * hh; }
DI void unpack8(const uint4& v, float* x) {
  x[0] = bflo(v.x); x[1] = bfhi(v.x); x[2] = bflo(v.y); x[3] = bfhi(v.y);
  x[4] = bflo(v.z); x[5] = bfhi(v.z); x[6] = bflo(v.w); x[7] = bfhi(v.w);
}
DI uint4 pack8(const float* x) {
  uint4 o; o.x = pack2(x[0], x[1]); o.y = pack2(x[2], x[3]); o.z = pack2(x[4], x[5]); o.w = pack2(x[6], x[7]);
  return o;
}

template <int WN, int PF = 2>
DI void gemm_ml(const u16* __restrict__ A, long lda, const u16* __restrict__ B, long ldb, int K,
                f32x16 (&acc)[2][WN], u16* sm) {
  const int tid = tidx(), lane = tid & 63, wave = tid >> 6, l31 = lane & 31, hh = lane >> 5;
  const int wm = wave >> 1, wn = wave & 1;
  const int chunk = tid & 7, row0 = tid >> 3;
  u16* sa = sm;
  u16* sb = sm + 2 * 128 * 72;
  struct Stg { u32x4 a0, a1, a2, a3, b0, b1, b2, b3; };
  Stg r0, r1;
  const u16* ga = A + (long)row0 * lda + chunk * 8;
  const u16* gb = B + (long)row0 * ldb + chunk * 8;
  const int nk = K >> 6;
#define GLOAD(R, kt_)                                            \
  {                                                              \
    const int ko = (kt_) * 64;                                   \
    R.a0 = *(const u32x4*)(ga + ko);                             \
    R.a1 = *(const u32x4*)(ga + 32 * lda + ko);                  \
    R.a2 = *(const u32x4*)(ga + 64 * lda + ko);                  \
    R.a3 = *(const u32x4*)(ga + 96 * lda + ko);                  \
    R.b0 = *(const u32x4*)(gb + ko);                             \
    R.b1 = *(const u32x4*)(gb + 32 * ldb + ko);                  \
    if (WN == 2) {                                               \
      R.b2 = *(const u32x4*)(gb + 64 * ldb + ko);                \
      R.b3 = *(const u32x4*)(gb + 96 * ldb + ko);                \
    }                                                            \
  }
#define SWRITE(R, buf_)                                                   \
  {                                                                       \
    u16* wa = sa + (buf_) * 128 * 72 + row0 * 72 + chunk * 8;             \
    u16* wb = sb + (buf_) * 128 * 72 + row0 * 72 + chunk * 8;             \
    *(u32x4*)(wa) = R.a0;                                                 \
    *(u32x4*)(wa + 32 * 72) = R.a1;                                       \
    *(u32x4*)(wa + 64 * 72) = R.a2;                                       \
    *(u32x4*)(wa + 96 * 72) = R.a3;                                       \
    *(u32x4*)(wb) = R.b0;                                                 \
    *(u32x4*)(wb + 32 * 72) = R.b1;                                       \
    if (WN == 2) {                                                        \
      *(u32x4*)(wb + 64 * 72) = R.b2;                                     \
      *(u32x4*)(wb + 96 * 72) = R.b3;                                     \
    }                                                                     \
  }
  auto compute = [&](int buf) {
    const u16* pa = sa + buf * 128 * 72 + (wm * 64 + l31) * 72 + hh * 8;
    const u16* pb = sb + buf * 128 * 72 + (wn * 32 * WN + l31) * 72 + hh * 8;
#pragma unroll
    for (int ks = 0; ks < 4; ++ks) {
      bf16x8 af[2], bfr[WN];
#pragma unroll
      for (int mt = 0; mt < 2; ++mt) af[mt] = *(const bf16x8*)(pa + mt * 32 * 72 + ks * 16);
#pragma unroll
      for (int nt = 0; nt < WN; ++nt) bfr[nt] = *(const bf16x8*)(pb + nt * 32 * 72 + ks * 16);
#pragma unroll
      for (int mt = 0; mt < 2; ++mt)
#pragma unroll
        for (int nt = 0; nt < WN; ++nt) acc[mt][nt] = MFMA(af[mt], bfr[nt], acc[mt][nt]);
    }
  };
  if (PF == 2) {
    GLOAD(r0, 0);
    if (nk > 1) GLOAD(r1, 1);
    SWRITE(r0, 0);
    __syncthreads();
#pragma unroll 1
    for (int kt = 0; kt < nk; kt += 2) {
      if (kt + 2 < nk) GLOAD(r0, kt + 2);
      compute(0);
      if (kt + 1 < nk) SWRITE(r1, 1);
      __syncthreads();
      if (kt + 1 >= nk) break;
      if (kt + 3 < nk) GLOAD(r1, kt + 3);
      compute(1);
      if (kt + 2 < nk) SWRITE(r0, 0);
      __syncthreads();
    }
  } else {
    GLOAD(r0, 0);
    SWRITE(r0, 0);
    __syncthreads();
#pragma unroll 1
    for (int kt = 0; kt < nk; ++kt) {
      const int buf = kt & 1;
      if (kt + 1 < nk) GLOAD(r0, kt + 1);
      compute(buf);
      if (kt + 1 < nk) SWRITE(r0, buf ^ 1);
      __syncthreads();
    }
  }
#undef GLOAD
#undef SWRITE
}

template <int WN>
DI void zero_acc(f32x16 (&acc)[2][WN]) {
#pragma unroll
  for (int mt = 0; mt < 2; ++mt)
#pragma unroll
    for (int nt = 0; nt < WN; ++nt)
#pragma unroll
      for (int r = 0; r < 16; ++r) acc[mt][nt][r] = 0.f;
}

template <int WN, class F>
DI void epi(f32x16 (&acc)[2][WN], F f) {
  const int lane = tidx() & 63, wave = tidx() >> 6, l31 = lane & 31, hh = lane >> 5;
  const int wm = wave >> 1, wn = wave & 1;
#pragma unroll
  for (int mt = 0; mt < 2; ++mt)
#pragma unroll
    for (int nt = 0; nt < WN; ++nt)
#pragma unroll
      for (int r = 0; r < 16; ++r)
        f(wm * 64 + mt * 32 + crow(r, hh), wn * 32 * WN + nt * 32 + l31, acc[mt][nt][r]);
}

DI void block_rstd(const u16* base, long ld, int ncols, float* out) {
  const int tid = tidx(), row = tid >> 1, half = tid & 1;
  const int n2 = ncols >> 1;
  const u16* p = base + (long)row * ld + half * n2;
  float ss = 0.f;
  for (int i = 0; i < n2; i += 8) {
    uint4 v = *(const uint4*)(p + i);
    float x[8]; unpack8(v, x);
#pragma unroll
    for (int j = 0; j < 8; ++j) ss += x[j] * x[j];
  }
  ss += __shfl_xor(ss, 1);
  if (half == 0) out[row] = rsqrtf(ss / (float)ncols + EPS);
}

template <class CM, class SC>
DI void convT(u16* dst, int N, int K, const float* __restrict__ src, long ld, CM cm, SC sc, long& rot) {
  const unsigned kblocks = (unsigned)K / 64u;
  const unsigned items = ((unsigned)N / 64u) * kblocks * 64u;
  const unsigned gth = (unsigned)VGRID * 256u;
  const unsigned gtid = (unsigned)bidx() * 256u + (unsigned)tidx();
  const unsigned r = (unsigned)rot;
  const unsigned i0 = gtid >= r ? gtid - r : gtid + gth - r;
  rot = (long)((r + items) % gth);
  for (unsigned i = i0; i < items; i += gth) {
    const int kq = (int)(i & 7u), nl = (int)((i >> 3) & 7u);
    const unsigned rest = i >> 6;
    const int kb = (int)(rest % kblocks), nb = (int)(rest / kblocks);
    const int n = nb * 64 + nl * 8, k0 = kb * 64 + kq * 8;
    const int c = cm(n);
    float4 xa[8], xb[8];
#pragma unroll
    for (int j = 0; j < 8; ++j) {
      xa[j] = make_float4(0.f, 0.f, 0.f, 0.f);
      xb[j] = xa[j];
      if (c >= 0) {
        const f32x4_t ta = __builtin_nontemporal_load((const f32x4_t*)(src + (long)(k0 + j) * ld + c));
        const f32x4_t tb = __builtin_nontemporal_load((const f32x4_t*)(src + (long)(k0 + j) * ld + c + 4));
        xa[j] = make_float4(ta[0], ta[1], ta[2], ta[3]);
        xb[j] = make_float4(tb[0], tb[1], tb[2], tb[3]);
      }
    }
    float v[8][8];
#pragma unroll
    for (int j = 0; j < 8; ++j) {
      const float w = sc(k0 + j);
      v[0][j] = xa[j].x * w; v[1][j] = xa[j].y * w; v[2][j] = xa[j].z * w; v[3][j] = xa[j].w * w;
      v[4][j] = xb[j].x * w; v[5][j] = xb[j].y * w; v[6][j] = xb[j].z * w; v[7][j] = xb[j].w * w;
    }
#pragma unroll
    for (int q = 0; q < 8; ++q) *(uint4*)(dst + (long)(n + q) * K + k0) = pack8(v[q]);
  }
}

DI void ph_wprep(const Params& p, int l) {
  char* ws = lws(p.ws);
  auto one = [](int) { return 1.f; };
  long rot = 0;
  const float* w_in = p.in[2] + (size_t)l * 1024 * INW;
  convT((u16*)(ws + O_WZ), 2560, 1024, w_in, INW,
        [](int n) { return n < 544 ? n : (n < 1056 ? n + 256 : (n < ZW ? n + 512 : -1)); }, one, rot);
  convT((u16*)(ws + O_WF), 512, 1024, w_in, INW, [](int n) { return n < 256 ? 544 + n : 1312 + (n - 256); }, one, rot);
  convT((u16*)(ws + O_WG), 4096, 1024, w_in, INW, [](int n) { return 2848 + n; }, one, rot);
  {
    const float* g = p.in[3] + l * 384;
    convT((u16*)(ws + O_WUQ), 384, 384, p.in[4] + (size_t)l * 384 * 384, 384, [](int n) { return n; },
          [g](int k) { return g[k]; }, rot);
  }
  {
    const float* g = p.in[5] + l * 128;
    const float* w = p.in[6] + (size_t)l * 128 * 512;
    convT((u16*)(ws + O_WKN), 256, 128, w, 512, [](int n) { return (n >> 6) * 128 + (n & 63); }, [g](int k) { return g[k]; }, rot);
    convT((u16*)(ws + O_WV), 256, 128, w, 512, [](int n) { return (n >> 6) * 128 + 64 + (n & 63); }, [g](int k) { return g[k]; }, rot);
  }
  const float* wb = p.in[18] + (size_t)l * 4 * 256 * 1024;
  convT((u16*)(ws + O_WB0), 1024, 256, wb, 1024, [](int n) { return n; }, one, rot);
  convT((u16*)(ws + O_WB2), 1024, 256, wb + 2 * 256 * 1024, 1024, [](int n) { return n; }, one, rot);
  convT((u16*)(ws + O_WB3), 1024, 256, wb + 3 * 256 * 1024, 1024, [](int n) { return n; }, one, rot);
  convT((u16*)(ws + O_WO), 1024, 1024, p.in[19] + (size_t)l * 1024 * 1024, 1024, [](int n) { return n; }, one, rot);
  convT((u16*)(ws + O_WGU), 5632, 1024, p.in[21] + (size_t)l * 1024 * 5632, 5632,
        [](int R) {
          const int tile = R >> 8, w = R & 255;
          const int col = tile * 128 + (w & 127);
          return (w >> 7) ? DFF + col : col;
        },
        one, rot);
  convT((u16*)(ws + O_WD), 1024, 2816, p.in[22] + (size_t)l * DFF * 1024, 1024, [](int n) { return n; }, one, rot);
  {
    u16* dst = (u16*)(ws + O_WB1);
    const float* w1 = wb + 1 * 256 * 1024;
    for (int i = bidx() * 256 + tidx(); i < 1024 * 512; i += VGRID * 256) {
      const int j = i & 1023, kk = i >> 10;
      const int sel = kk >> 8, g = (kk >> 6) & 3, cc = kk & 63;
      float a = 0.f;
#pragma unroll 16
      for (int c2 = 0; c2 < 64; ++c2) {
        const float fr = (float)((cc * c2) & 63) * (1.f / 64.f);
        const float tr = sel ? -__builtin_amdgcn_sinf(fr) : __builtin_amdgcn_cosf(fr);
        a += tr * w1[(g * 64 + c2) * 1024 + j];
      }
      dst[j * 512 + kk] = f2bf(a * 0.125f);
    }
  }
  if (l == 0) {
    float* rc = (float*)(ws + O_RC);
    float* rs = (float*)(ws + O_RS);
    for (int i = bidx() * 256 + tidx(); i < 8192 * 16; i += VGRID * 256) {
      const int pos = i >> 4, fi = i & 15;
      const float invf = 1.0f / exp2f((float)fi * 0.8304820237218407f);
      const float ang = (float)pos * invf;
      double rv = (double)ang * 0.15915494309189535;
      rv -= floor(rv);
      const float fr = (float)rv;
      rc[i] = __builtin_amdgcn_cosf(fr);
      rs[i] = __builtin_amdgcn_sinf(fr);
    }
    u16* e1 = (u16*)(ws + O_E1);
    for (int i = bidx() * 256 + tidx(); i < 256 * 128; i += VGRID * 256) {
      const int R = i >> 7, s1 = i & 127;
      const int p1 = (R >> 7) * 64 + ((R >> 6) & 1) * 32 + (R & 31), ri = (R >> 5) & 1;
      const float fr = (float)((p1 * s1) & 127) * (1.f / 128.f);
      const float v = ri ? -__builtin_amdgcn_sinf(fr) : __builtin_amdgcn_cosf(fr);
      e1[i] = f2bf(v * 0.08838834764831845f);
    }
    u16* e2 = (u16*)(ws + O_E2);
    for (int i = bidx() * 256 + tidx(); i < 128 * 128; i += VGRID * 256) {
      const int R = i >> 7, kk = i & 127;
      const int sel = R >> 6, p2 = R & 63, s2 = kk >> 1, ri = kk & 1;
      const float fr = (float)((p2 * s2) & 63) * (1.f / 64.f);
      const float c = __builtin_amdgcn_cosf(fr), s = __builtin_amdgcn_sinf(fr);
      const float v = sel == 0 ? (ri == 0 ? c : s) : (ri == 0 ? s : -c);
      e2[i] = f2bf(v * 0.125f);
    }
  }
}

DI void ph_rmsnorm(const float* __restrict__ x, const float* __restrict__ g, u16* __restrict__ H) {
  const int lane = tidx() & 63, wave = tidx() >> 6;
  const int nw = VGRID * 4;
#pragma unroll 1
  for (int row0 = (bidx() * 4 + wave) * 4; row0 < T; row0 += nw * 4) {
    float4 v[4][4];
#pragma unroll
    for (int q = 0; q < 4; ++q) {
      const float4* xr = (const float4*)(x + (size_t)(row0 + q) * 1024);
#pragma unroll
      for (int i = 0; i < 4; ++i) {
        const f32x4_t t4 = __builtin_nontemporal_load((const f32x4_t*)(xr + lane + 64 * i));
        v[q][i] = make_float4(t4[0], t4[1], t4[2], t4[3]);
      }
    }
    float4 gg[4];
#pragma unroll
    for (int i = 0; i < 4; ++i) gg[i] = ((const float4*)g)[lane + 64 * i];
#pragma unroll
    for (int q = 0; q < 4; ++q) {
      float ss = 0.f;
#pragma unroll
      for (int i = 0; i < 4; ++i) ss += v[q][i].x * v[q][i].x + v[q][i].y * v[q][i].y + v[q][i].z * v[q][i].z + v[q][i].w * v[q][i].w;
#pragma unroll
      for (int o = 32; o >= 1; o >>= 1) ss += __shfl_xor(ss, o);
      const float r = rsqrtf(ss * (1.f / 1024.f) + EPS);
#pragma unroll
      for (int i = 0; i < 4; ++i) {
        uint2 o;
        o.x = pack2(v[q][i].x * r * gg[i].x, v[q][i].y * r * gg[i].y);
        o.y = pack2(v[q][i].z * r * gg[i].z, v[q][i].w * r * gg[i].w);
        *(uint2*)(H + (size_t)(row0 + q) * 1024 + (lane + 64 * i) * 4) = o;
      }
    }
  }
}


namespace pg8 {
#define PG8_LAS __attribute__((address_space(3)))
typedef unsigned short bf16_t;
typedef short bf16x8 __attribute__((ext_vector_type(8)));
typedef float f32x4 __attribute__((ext_vector_type(4)));
typedef unsigned u32x4 __attribute__((ext_vector_type(4)));
constexpr int BM = 256, BK = 64, HALF = 128, HTB = HALF * BK * 2  , STAGE_BYTES = 8 * HTB, NXCD = 8, WGM = 8;

__host__ __device__ __forceinline__ int lds_byte(int r, int c) { const int st = (r >> 4) * 2 + (c >> 5), rr = r & 15, cc = c & 31, ob = rr * 64 + cc * 2; return st * 1024 + (ob ^ (((ob >> 9) & 1) << 5)); }
__host__ __device__ __forceinline__ void stage_rc(int b, int& R, int& C) { const int st = b / 1024, sb = b % 1024, swz = sb ^ (((sb >> 9) & 1) << 5); R = (st >> 1) * 16 + swz / 64; C = (st & 1) * 32 + (swz % 64) / 2; }
__host__ __device__ __forceinline__ int perm32(int rho) { const int n = rho >> 4, i = rho & 15; return 8 * (i >> 2) + 4 * n + (i & 3); }

struct Unit { int pm, pn; };
struct Gemm { const bf16_t* A; const bf16_t* Bt; int M, N, K; };

struct StaticOrder {
    static constexpr bool CUSTOM_B = false;
    __device__ __forceinline__ int ldb_() const { return 0; }
    __device__ __forceinline__ size_t hstepB_() const { return 0; }
    __device__ __forceinline__ const char* bbase_(const Gemm&, const Unit&) const { return nullptr; }
    int nM, nN, nwg, G, c;
    __host__ __device__ void init(int M, int N, int G_, int c_) { nM = M / BM; nN = N / BM; nwg = nM * nN; G = G_; c = c_; }
    __host__ __device__ bool next(int i, Unit& u) const {
        const long L = (long)i * G + c; if (L >= nwg) return false;
        int wgid = (int)L; { const int q = nwg / NXCD, r = nwg % NXCD, xcd = wgid % NXCD, off = wgid / NXCD; wgid = (xcd < r ? xcd * (q + 1) : r * (q + 1) + (xcd - r) * q) + off; }
        const int nig = WGM * nN, gid = wgid / nig, fm = gid * WGM, gsz = (nM - fm) < WGM ? (nM - fm) : WGM;
        u.pm = fm + ((wgid % nig) % gsz); u.pn = (wgid % nig) / gsz; return true;
    }
    __device__ __forceinline__ void a_ready(const Unit&) const {}
    __device__ __forceinline__ void done(const Unit&) const {}
};
template <class Epi, class Sched, bool STAMP = false>
__device__ __forceinline__ void gemm_phase(PG8_LAS unsigned char* lds, const Gemm g, const Sched& S, const Epi& E, unsigned long long* stamps) {
    int tid_ = threadIdx.x; asm volatile("" : "+v"(tid_));
    const int tid = tid_, wid = __builtin_amdgcn_readfirstlane(tid >> 6), lane = tid & 63, wr = wid >> 2, wc = wid & 3, fr = lane & 15, fq = lane >> 4;
    const int K = g.K, nt = K / BK;
    int ts_lo = 0, ts_hi = 0, nts = 0; const unsigned long long rt_entry = STAMP ? (unsigned long long)wall_clock64() : 0ull;
#define PG8_STAMP() do { if (STAMP && wid == 0 && nts < 64) { const unsigned long long _c = (unsigned long long)clock64(); \
        ts_lo = (lane == nts) ? (int)(unsigned)_c : ts_lo; ts_hi = (lane == nts) ? (int)(unsigned)(_c >> 32) : ts_hi; ++nts; } } while (0)
    PG8_STAMP();
    unsigned voffA[2], voffB[2];
#pragma unroll
    for (int i = 0; i < 2; ++i) { int R, C; stage_rc(tid * 16 + i * 8192, R, C); const int Rb = Epi::PERM ? ((R & ~31) + perm32(R & 31)) : R;
        voffA[i] = (unsigned)(R * K + C) * 2u; voffB[i] = (unsigned)(Rb * (Sched::CUSTOM_B ? S.ldb_() : K) + C) * 2u; }
    const size_t kstep = (size_t)(BK * 2);
    const size_t hstep = (size_t)HALF * K * 2;
    const size_t tstep = 2 * hstep;
    const size_t hstepB = Sched::CUSTOM_B ? S.hstepB_() : hstep;
    const unsigned ldsw = (unsigned)wid * 1024u;
    const int aoff = lds_byte(wr * 64 + fr, fq * 8), boff = lds_byte(wc * 32 + fr, fq * 8);
#define PG8_SA(b, h) (((b) * 2 + (h)) * HTB)
#define PG8_SB(b, h) ((4 + (b) * 2 + (h)) * HTB)
#define PG8_STAGE(bufoff, gbase, voff) do { _Pragma("unroll") for (int _i = 0; _i < 2; ++_i) \
        __builtin_amdgcn_global_load_lds((const unsigned*)((const char*)(gbase) + (voff)[_i]), (PG8_LAS unsigned*)(lds + (bufoff) + ldsw + _i * 8192), 16, 0, 0); } while (0)
#define PG8_LDA(dst, b, h) do { _Pragma("unroll") for (int m = 0; m < 4; ++m) _Pragma("unroll") for (int k = 0; k < 2; ++k) dst[m][k] = *(const PG8_LAS bf16x8*)(lds + PG8_SA(b, h) + aoff + m * 2048 + k * 1024); } while (0)
#define PG8_LDB(dst, b, h) do { _Pragma("unroll") for (int n = 0; n < 2; ++n) _Pragma("unroll") for (int k = 0; k < 2; ++k) dst[n][k] = *(const PG8_LAS bf16x8*)(lds + PG8_SB(b, h) + boff + n * 2048 + k * 1024); } while (0)
#define PG8_MMA(ai, bj, At, Bt) do { __builtin_amdgcn_s_setprio(1); _Pragma("unroll") for (int m = 0; m < 4; ++m) _Pragma("unroll") for (int n = 0; n < 2; ++n) _Pragma("unroll") for (int k = 0; k < 2; ++k) \
        acc[ai][bj][m][n] = __builtin_amdgcn_mfma_f32_16x16x32_bf16(Bt[n][k], At[m][k], acc[ai][bj][m][n], 0, 0, 0); __builtin_amdgcn_s_setprio(0); } while (0)
#define PG8_WAIT_V(n) asm volatile("s_waitcnt vmcnt(" #n ")" ::: "memory")
#define PG8_WAIT_L(n) asm volatile("s_waitcnt lgkmcnt(" #n ")" ::: "memory")
#define PG8_BAR __builtin_amdgcn_s_barrier()
#define PG8_SCHED __builtin_amdgcn_sched_barrier(0)
    Unit cur, nxt; int ui = 0;
    if (!S.next(0, cur)) return;
    f32x4 acc[2][2][4][2];
#pragma unroll
    for (int a = 0; a < 2; ++a)
#pragma unroll
        for (int b = 0; b < 2; ++b)
#pragma unroll
            for (int m = 0; m < 4; ++m)
#pragma unroll
                for (int n = 0; n < 2; ++n) acc[a][b][m][n] = (f32x4){0.f, 0.f, 0.f, 0.f};
    bf16x8 At[4][2], B0[2][2], B1[2][2];
    const char* cA = (const char*)g.A + (size_t)cur.pm * tstep; const char* cB = Sched::CUSTOM_B ? S.bbase_(g, cur) : (const char*)g.Bt + (size_t)cur.pn * tstep;
    S.a_ready(cur);
    PG8_STAGE(PG8_SB(0, 0), cB, voffB); PG8_STAGE(PG8_SA(0, 0), cA, voffA); PG8_STAGE(PG8_SB(0, 1), cB + hstepB, voffB); PG8_STAGE(PG8_SA(0, 1), cA + hstep, voffA);
    if (wr == 1) PG8_BAR;
    PG8_WAIT_V(4); PG8_BAR;
    PG8_STAGE(PG8_SB(1, 0), cB + kstep, voffB); PG8_STAGE(PG8_SA(1, 0), cA + kstep, voffA); PG8_STAGE(PG8_SB(1, 1), cB + hstepB + kstep, voffB);
    PG8_WAIT_V(6); PG8_BAR;
    PG8_STAMP();
    for (;;) {
        const bool has_next = S.next(ui + 1, nxt);
        const char* nA = has_next ? (const char*)g.A + (size_t)nxt.pm * tstep : cA; const char* nB = has_next ? (Sched::CUSTOM_B ? S.bbase_(g, nxt) : (const char*)g.Bt + (size_t)nxt.pn * tstep) : cB;
        for (int t = 0; t < nt; t += 2) {
            const bool last = (t == nt - 2);
            const char* a1 = cA + (size_t)(t + 1) * kstep;
            const char* a2 = last ? nA : cA + (size_t)(t + 2) * kstep; const char* b2 = last ? nB : cB + (size_t)(t + 2) * kstep;
            const char* a3 = a2 + kstep; const char* b3 = b2 + kstep;
            if (last && has_next) S.a_ready(nxt);
            PG8_LDB(B0, 0, 0); PG8_SCHED; PG8_LDA(At, 0, 0); PG8_STAGE(PG8_SA(1, 1), a1 + hstep, voffA);
            PG8_WAIT_L(8); PG8_BAR; PG8_WAIT_L(0); PG8_MMA(0, 0, At, B0); PG8_BAR; PG8_SCHED;
            PG8_LDB(B1, 0, 1); PG8_STAGE(PG8_SB(0, 0), b2, voffB);
            PG8_BAR; PG8_WAIT_L(0); PG8_MMA(0, 1, At, B1); PG8_BAR;
            PG8_LDA(At, 0, 1); PG8_STAGE(PG8_SA(0, 0), a2, voffA);
            PG8_BAR; PG8_WAIT_L(0); PG8_MMA(1, 0, At, B0); PG8_BAR; PG8_SCHED;
            PG8_STAGE(PG8_SB(0, 1), b2 + hstepB, voffB);
            PG8_WAIT_V(6); PG8_BAR; PG8_MMA(1, 1, At, B1); PG8_BAR;
            PG8_LDB(B0, 1, 0); PG8_SCHED; PG8_LDA(At, 1, 0); PG8_STAGE(PG8_SA(0, 1), a2 + hstep, voffA);
            PG8_WAIT_L(8); PG8_BAR; PG8_WAIT_L(0); PG8_MMA(0, 0, At, B0); PG8_BAR; PG8_SCHED;
            PG8_LDB(B1, 1, 1); PG8_STAGE(PG8_SB(1, 0), b3, voffB);
            PG8_BAR; PG8_WAIT_L(0); PG8_MMA(0, 1, At, B1); PG8_BAR;
            PG8_LDA(At, 1, 1); PG8_STAGE(PG8_SA(1, 0), a3, voffA);
            PG8_BAR; PG8_WAIT_L(0); PG8_MMA(1, 0, At, B0); PG8_BAR; PG8_SCHED;
            PG8_STAGE(PG8_SB(1, 1), b3 + hstepB, voffB);
            PG8_WAIT_V(6); PG8_BAR; PG8_MMA(1, 1, At, B1); PG8_BAR;
        }
        PG8_STAMP();
        if constexpr (!Epi::AFTER_DRAIN) { E(acc, cur, wr, wc, fr, fq); S.done(cur); }
        PG8_STAMP();
        if (!has_next) break;
#pragma unroll
        for (int a = 0; a < 2; ++a)
#pragma unroll
            for (int b = 0; b < 2; ++b)
#pragma unroll
                for (int m = 0; m < 4; ++m)
#pragma unroll
                    for (int n = 0; n < 2; ++n) acc[a][b][m][n] = (f32x4){0.f, 0.f, 0.f, 0.f};
        cur = nxt; cA = nA; cB = nB; ++ui;
    }
    PG8_WAIT_V(0);
    if (wr == 0) PG8_BAR;
    PG8_BAR;
    if constexpr (Epi::AFTER_DRAIN) { E.fused(acc, cur, wr, wc, fr, fq, lds, wid, lane); S.done(cur); }
    PG8_STAMP();
    if (STAMP && wid == 0) { stamps[lane] = lane < nts ? (((unsigned long long)(unsigned)ts_hi << 32) | (unsigned)ts_lo) : 0ull;
        if (lane == 62) stamps[62] = rt_entry; if (lane == 63) stamps[63] = (unsigned long long)wall_clock64(); }
#undef PG8_STAMP
#undef PG8_SA
#undef PG8_SB
#undef PG8_STAGE
#undef PG8_LDA
#undef PG8_LDB
#undef PG8_MMA
#undef PG8_WAIT_V
#undef PG8_WAIT_L
#undef PG8_BAR
#undef PG8_SCHED
}
}

struct EpiZ {
  static constexpr bool PERM = true, AFTER_DRAIN = false;
  u16* Z;
  DI void operator()(const pg8::f32x4 (&acc)[2][2][4][2], const pg8::Unit& u, int wr, int wc, int fr, int fq) const {
    const int row0 = u.pm * 256 + wr * 64 + fr, col0 = u.pn * 256 + wc * 32 + 8 * fq;
#pragma unroll
    for (int ai = 0; ai < 2; ++ai)
#pragma unroll
      for (int m = 0; m < 4; ++m) {
        u16* rowp = Z + (size_t)(row0 + ai * 128 + m * 16) * ZW;
#pragma unroll
        for (int bj = 0; bj < 2; ++bj) {
          const int col = col0 + bj * 128;
          if (col < ZW) {
            const pg8::f32x4 v0 = acc[ai][bj][m][0], v1 = acc[ai][bj][m][1];
            u32x4 w;
            w[0] = pack2(v0[0], v0[1]); w[1] = pack2(v0[2], v0[3]); w[2] = pack2(v1[0], v1[1]); w[3] = pack2(v1[2], v1[3]);
            *(u32x4*)(rowp + col) = w;
          }
        }
      }
  }
};
struct EpiRes {
  static constexpr bool PERM = false, AFTER_DRAIN = false;
  const float* xin;
  float* xout;
  DI void operator()(const pg8::f32x4 (&acc)[2][2][4][2], const pg8::Unit& u, int wr, int wc, int fr, int fq) const {
    const int row0 = u.pm * 256 + wr * 64 + fr, col0 = u.pn * 256 + wc * 32 + 4 * fq;
    pg8::f32x4 xc[2][2], xn[2][2];
#pragma unroll
    for (int bj = 0; bj < 2; ++bj)
#pragma unroll
      for (int n = 0; n < 2; ++n) xn[bj][n] = *(const pg8::f32x4*)(xin + (size_t)row0 * 1024 + col0 + bj * 128 + n * 16);
#pragma unroll
    for (int g = 0; g < 8; ++g) {
      const int ai = g >> 2, m = g & 3;
      const size_t off = (size_t)(row0 + ai * 128 + m * 16) * 1024 + col0;
#pragma unroll
      for (int bj = 0; bj < 2; ++bj)
#pragma unroll
        for (int n = 0; n < 2; ++n) xc[bj][n] = xn[bj][n];
      if (g + 1 < 8) {
        const int ai2 = (g + 1) >> 2, m2 = (g + 1) & 3;
        const size_t off2 = (size_t)(row0 + ai2 * 128 + m2 * 16) * 1024 + col0;
#pragma unroll
        for (int bj = 0; bj < 2; ++bj)
#pragma unroll
          for (int n = 0; n < 2; ++n) xn[bj][n] = *(const pg8::f32x4*)(xin + off2 + bj * 128 + n * 16);
      }
#pragma unroll
      for (int bj = 0; bj < 2; ++bj)
#pragma unroll
        for (int n = 0; n < 2; ++n) *(pg8::f32x4*)(xout + off + bj * 128 + n * 16) = xc[bj][n] + acc[ai][bj][m][n];
    }
  }
};
struct EpiSwi {
  static constexpr bool PERM = true, AFTER_DRAIN = false;
  u16* ACT;
  DI void operator()(const pg8::f32x4 (&acc)[2][2][4][2], const pg8::Unit& u, int wr, int wc, int fr, int fq) const {
    const int row0 = u.pm * 256 + wr * 64 + fr, col0 = u.pn * 128 + wc * 32 + 8 * fq;
#pragma unroll
    for (int ai = 0; ai < 2; ++ai)
#pragma unroll
      for (int m = 0; m < 4; ++m) {
        float a[8];
#pragma unroll
        for (int n = 0; n < 2; ++n)
#pragma unroll
          for (int j = 0; j < 4; ++j) {
            const float g = acc[ai][0][m][n][j], up = acc[ai][1][m][n][j];
            a[n * 4 + j] = g * sigmoid_fast(g) * up;
          }
        u32x4 w;
        w[0] = pack2(a[0], a[1]); w[1] = pack2(a[2], a[3]); w[2] = pack2(a[4], a[5]); w[3] = pack2(a[6], a[7]);
        *(u32x4*)(ACT + (size_t)(row0 + ai * 128 + m * 16) * DFF + col0) = w;
      }
  }
};

struct EpiSig {
  static constexpr bool PERM = true, AFTER_DRAIN = false;
  u16* G;
  DI void operator()(const pg8::f32x4 (&acc)[2][2][4][2], const pg8::Unit& u, int wr, int wc, int fr, int fq) const {
    const int row0 = u.pm * 256 + wr * 64 + fr, col0 = u.pn * 256 + wc * 32 + 8 * fq;
#pragma unroll
    for (int ai = 0; ai < 2; ++ai)
#pragma unroll
      for (int m = 0; m < 4; ++m) {
        u16* rowp = G + (size_t)(row0 + ai * 128 + m * 16) * 4096 + col0;
#pragma unroll
        for (int bj = 0; bj < 2; ++bj) {
          const pg8::f32x4 v0 = acc[ai][bj][m][0], v1 = acc[ai][bj][m][1];
          u32x4 w;
          w[0] = pack2(sigmoid_fast(v0[0]), sigmoid_fast(v0[1])); w[1] = pack2(sigmoid_fast(v0[2]), sigmoid_fast(v0[3]));
          w[2] = pack2(sigmoid_fast(v1[0]), sigmoid_fast(v1[1])); w[3] = pack2(sigmoid_fast(v1[2]), sigmoid_fast(v1[3]));
          *(u32x4*)(rowp + bj * 128) = w;
        }
      }
  }
};

struct EpiMrg {
  static constexpr bool PERM = true, AFTER_DRAIN = false;
  const u16* G;
  u16* MG;
  bool FIRST;
  DI void operator()(const pg8::f32x4 (&acc)[2][2][4][2], const pg8::Unit& u, int wr, int wc, int fr, int fq) const {
    const int row0 = u.pm * 256 + wr * 64 + fr, col0 = u.pn * 256 + wc * 32 + 8 * fq;
    u32x4 gn[2][2];
#pragma unroll
    for (int mm = 0; mm < 2; ++mm)
#pragma unroll
      for (int bj = 0; bj < 2; ++bj) gn[mm][bj] = __builtin_nontemporal_load((const u32x4*)(G + (size_t)(row0 + mm * 16) * 4096 + col0 + bj * 128));
#pragma unroll
    for (int bt = 0; bt < 4; ++bt) {
      const int ai = bt >> 1, mp = bt & 1;
      u32x4 gv[2][2], mv[2][2];
#pragma unroll
      for (int mm = 0; mm < 2; ++mm)
#pragma unroll
        for (int bj = 0; bj < 2; ++bj) {
          const size_t row = (size_t)(row0 + ai * 128 + (2 * mp + mm) * 16);
          gv[mm][bj] = gn[mm][bj];
          mv[mm][bj] = (u32x4){0u, 0u, 0u, 0u};
          if (!FIRST) mv[mm][bj] = *(const u32x4*)(MG + row * 1024 + col0 + bj * 128);
        }
      if (bt + 1 < 4) {
        const int ai2 = (bt + 1) >> 1, mp2 = (bt + 1) & 1;
#pragma unroll
        for (int mm = 0; mm < 2; ++mm)
#pragma unroll
          for (int bj = 0; bj < 2; ++bj)
            gn[mm][bj] = __builtin_nontemporal_load((const u32x4*)(G + (size_t)(row0 + ai2 * 128 + (2 * mp2 + mm) * 16) * 4096 + col0 + bj * 128));
      }
#pragma unroll
      for (int mm = 0; mm < 2; ++mm)
#pragma unroll
        for (int bj = 0; bj < 2; ++bj) {
          const size_t row = (size_t)(row0 + ai * 128 + (2 * mp + mm) * 16);
          const int col = col0 + bj * 128;
          const pg8::f32x4 v0 = acc[ai][bj][2 * mp + mm][0], v1 = acc[ai][bj][2 * mp + mm][1];
          const u32x4 g4 = gv[mm][bj], m4 = mv[mm][bj];
          float o[8];
          o[0] = bflo(m4[0]) + bflo(g4[0]) * v0[0]; o[1] = bfhi(m4[0]) + bfhi(g4[0]) * v0[1];
          o[2] = bflo(m4[1]) + bflo(g4[1]) * v0[2]; o[3] = bfhi(m4[1]) + bfhi(g4[1]) * v0[3];
          o[4] = bflo(m4[2]) + bflo(g4[2]) * v1[0]; o[5] = bfhi(m4[2]) + bfhi(g4[2]) * v1[1];
          o[6] = bflo(m4[3]) + bflo(g4[3]) * v1[2]; o[7] = bfhi(m4[3]) + bfhi(g4[3]) * v1[3];
          u32x4 w;
          w[0] = pack2(o[0], o[1]); w[1] = pack2(o[2], o[3]); w[2] = pack2(o[4], o[5]); w[3] = pack2(o[6], o[7]);
          *(u32x4*)(MG + row * 1024 + col) = w;
        }
      asm volatile("" ::: "memory");
    }
  }
};

struct FeatOrder {
  static constexpr bool CUSTOM_B = true;
  int c;
  DI bool fnet() const { return c < 128; }
  DI int ldb_() const { return fnet() ? 64 * 1024 : 1024; }
  DI size_t hstepB_() const { return fnet() ? (size_t)1024 * 2 : (size_t)128 * 1024 * 2; }
  DI const char* bbase_(const pg8::Gemm& g, const pg8::Unit& u) const {
    if (fnet()) { const int b = u.pn >> 5, q = u.pn & 31; return (const char*)g.Bt + ((size_t)b * 8192 + 2 * q) * 1024 * 2; }
    return (const char*)g.Bt + (size_t)u.pn * 256 * 1024 * 2;
  }
  DI bool next(int i, pg8::Unit& u) const {
    if (i > 0) return false;
    u.pm = fnet() ? 0 : 1;
    u.pn = fnet() ? c : c - 128;
    return true;
  }
  DI void a_ready(const pg8::Unit&) const {}
  DI void done(const pg8::Unit&) const {}
};
struct EpiFeat {
  static constexpr bool PERM = true, AFTER_DRAIN = false;
  u16* UT;
  u16* VDT;
  DI void operator()(const pg8::f32x4 (&acc)[2][2][4][2], const pg8::Unit& u, int wr, int wc, int fr, int fq) const {
    const int feat0 = wr * 64 + fr, j0 = wc * 32 + 8 * fq;
#pragma unroll
    for (int ai = 0; ai < 2; ++ai)
#pragma unroll
      for (int m = 0; m < 4; ++m) {
        const int feat = feat0 + ai * 128 + m * 16;
#pragma unroll
        for (int bj = 0; bj < 2; ++bj) {
          const int j = j0 + bj * 128;
          const pg8::f32x4 v0 = acc[ai][bj][m][0], v1 = acc[ai][bj][m][1];
          u32x4 w;
          w[0] = pack2(v0[0], v0[1]); w[1] = pack2(v0[2], v0[3]); w[2] = pack2(v1[0], v1[1]); w[3] = pack2(v1[2], v1[3]);
          if (u.pm == 0) {
            const int b = u.pn >> 5, s2 = 2 * (u.pn & 31) + (j >> 7), s1 = j & 127;
            *(u32x4*)(UT + (((size_t)b * 256 + feat) * 64 + s2) * 128 + s1) = w;
          } else {
            *(u32x4*)(VDT + (size_t)feat * T + (size_t)u.pn * 256 + j) = w;
          }
        }
      }
  }
};

template <class Epi>
DI void run_gemm8(u16* sm_all, const u16* A, const u16* Bt, int M, int N, int K, const Epi& E) {
  pg8::Gemm g;
  g.A = A; g.Bt = Bt; g.M = M; g.N = N; g.K = K;
  pg8::StaticOrder S;
  S.init(M, N, (int)gridDim.x, (int)blockIdx.x);
  pg8::gemm_phase<Epi, pg8::StaticOrder, false>((PG8_LAS unsigned char*)sm_all, g, S, E, nullptr);
}

DI void ph_inproj(const Params& p, u16* sm) {
  char* ws = lws(p.ws);
  const u16* H = (const u16*)(ws + O_H);
  u16* UT = (u16*)(ws + O_UT);
  u16* VDT = (u16*)(ws + O_VDT);
#pragma unroll 1
  for (int j = bidx(); j < 4 * 256; j += VGRID) {
    f32x16 acc[2][2];
    zero_acc<2>(acc);
    const int tmf = j & 3, nt = j >> 2;
    const u16* A = (const u16*)(ws + O_WF) + (size_t)tmf * 128 * 1024;
    if (tmf < 2) {
      const int b = nt >> 6, s2 = nt & 63;
      gemm_ml<2>(A, 1024, H + ((size_t)b * 8192 + s2) * 1024, 64 * 1024, 1024, acc, sm);
      epi<2>(acc, [&](int m, int n, float v) {
        const int c = tmf * 128 + m;
        UT[(((size_t)b * 256 + c) * 64 + s2) * 128 + n] = f2bf(v);
      });
    } else {
      gemm_ml<2>(A, 1024, H + (size_t)nt * 128 * 1024, 1024, 1024, acc, sm);
      epi<2>(acc, [&](int m, int n, float v) {
        const int feat = (tmf - 2) * 128 + m;
        VDT[(size_t)feat * T + nt * 128 + n] = f2bf(v);
      });
    }
  }
}

DI float hgrn_lb(const Params& p, int l, int dir, int ch) {
  if (l == 0) return 0.f;
  const float* lg = p.in[16] + dir * 2 * 256;
  const float x0 = lg[ch], x1 = lg[256 + ch];
  return 1.f / (1.f + expf(x0 - x1));
}

DI void hgrn_gates(const u16 (&zraw)[16], float lb, int dir, int w, int k, float* tot  ,
                   float (&cum)[16], float (&kk)[16], float& total) {
  float lf[16];
#pragma unroll
  for (int j = 0; j < 16; ++j) {
    const float z = bf2f(zraw[j]);
    const float sg = __builtin_amdgcn_rcpf(1.f + __expf(-z));
    const float f = lb + (1.f - lb) * sg;
    lf[j] = __logf(f);
    kk[j] = 1.f - f;
  }
  float pre[16];
  float run = 0.f;
#pragma unroll
  for (int j = 0; j < 16; ++j) { run += lf[j]; pre[j] = run; }
  tot[w * 64 + k] = run;
  __syncthreads();
  const float t0 = tot[k], t1 = tot[64 + k], t2 = tot[128 + k], t3 = tot[192 + k];
  total = t0 + t1 + t2 + t3;
  float before = 0.f;
  if (w > 0) before += t0;
  if (w > 1) before += t1;
  if (w > 2) before += t2;
  const float after = total - before - run;
#pragma unroll
  for (int j = 0; j < 16; ++j) cum[j] = dir ? (after + run - pre[j] + lf[j]) : (before + pre[j]);
}

DI void hgrn_h1_load(const Params& p, int item, u16 (&zraw)[16], u16 (&vraw)[16]) {
  const u16* Z = (const u16*)(p.ws + O_Z);
  const int chunk = item & 127, dir = (item >> 7) & 1, h = (item >> 8) & 3, b = item >> 10;
  const int tid = tidx(), k = tid & 63, w = tid >> 6;
  const size_t tok0 = (size_t)b * 8192 + chunk * 64;
  const u16* zc = Z + (tok0 + w * 16) * ZW + h * 64 + k;
#pragma unroll
  for (int j = 0; j < 16; ++j) { zraw[j] = zc[(size_t)j * ZW + (dir ? 1824 : 1568)]; vraw[j] = zc[(size_t)j * ZW + 1312]; }
}
DI void hgrn_h1(const Params& p, int l, int item, u16* sm, const u16 (&zraw)[16], const u16 (&vraw)[16]) {
  char* ws = lws(p.ws);
  u16* ST = (u16*)(ws + O_ST);
  float* DEC = (float*)(ws + O_DEC);
  const int chunk = item & 127, dir = (item >> 7) & 1, h = (item >> 8) & 3, b = item >> 10;
  const int tid = tidx(), k = tid & 63, w = tid >> 6, lane = tid & 63, l31 = lane & 31, hh = lane >> 5;
  const size_t tok0 = (size_t)b * 8192 + chunk * 64;
  u16* KT = sm;
  u16* VT = sm + 64 * 72;
  float* tot = (float*)(sm + 2 * 64 * 72);
  float cum[16], kk[16], total;
  hgrn_gates(zraw, hgrn_lb(p, l, dir, h * 64 + k), dir, w, k, tot, cum, kk, total);
  float kv[16], vv[16];
#pragma unroll
  for (int j = 0; j < 16; ++j) {
    kv[j] = kk[j] * __expf(total - cum[j]);
    vv[j] = bf2f(vraw[j]);
  }
  *(uint4*)(KT + k * 72 + w * 16) = pack8(kv);
  *(uint4*)(KT + k * 72 + w * 16 + 8) = pack8(kv + 8);
  *(uint4*)(VT + k * 72 + w * 16) = pack8(vv);
  *(uint4*)(VT + k * 72 + w * 16 + 8) = pack8(vv + 8);
  if (w == 0) DEC[(size_t)item * 64 + k] = expf(total);
  __syncthreads();
  const int mt = w >> 1, nt = w & 1;
  f32x16 acc;
#pragma unroll
  for (int r = 0; r < 16; ++r) acc[r] = 0.f;
#pragma unroll
  for (int ks = 0; ks < 4; ++ks) {
    const bf16x8 a = *(const bf16x8*)(VT + (mt * 32 + l31) * 72 + ks * 16 + hh * 8);
    const bf16x8 bq = *(const bf16x8*)(KT + (nt * 32 + l31) * 72 + ks * 16 + hh * 8);
    acc = MFMA(a, bq, acc);
  }
#pragma unroll
  for (int r = 0; r < 16; ++r) ST[(size_t)item * 4096 + (mt * 32 + crow(r, hh)) * 64 + nt * 32 + l31] = f2bf(acc[r]);
  __syncthreads();
}

DI void hgrn_h2(const Params& p) {
  char* ws = lws(p.ws);
  u16* ST = (u16*)(ws + O_ST);
  const float* DEC = (const float*)(ws + O_DEC);
  for (int pi = bidx() * 256 + tidx(); pi < 32 * 2048; pi += VGRID * 256) {
    const int chain = pi >> 11, e2 = pi & 2047, dir = chain & 1;
    const int k = (2 * e2) & 63;
    float s0 = 0.f, s1 = 0.f;
#pragma unroll 1
    for (int c0 = 0; c0 < 128; c0 += 16) {
      unsigned uv[16];
      float2 dv[16];
#pragma unroll
      for (int j = 0; j < 16; ++j) {
        const int chunk = dir ? 127 - (c0 + j) : (c0 + j);
        const size_t item = (size_t)chain * 128 + chunk;
        uv[j] = *(const unsigned*)(ST + item * 4096 + 2 * e2);
        dv[j] = *(const float2*)(DEC + item * 64 + k);
      }
#pragma unroll
      for (int j = 0; j < 16; ++j) {
        const int chunk = dir ? 127 - (c0 + j) : (c0 + j);
        const size_t item = (size_t)chain * 128 + chunk;
        *(unsigned*)(ST + item * 4096 + 2 * e2) = pack2(s0, s1);
        s0 = dv[j].x * s0 + bflo(uv[j]);
        s1 = dv[j].y * s1 + bfhi(uv[j]);
      }
    }
  }
}

DI void hgrn_h3(const Params& p, int l, int item, u16* sm) {
  char* ws = lws(p.ws);
  const u16* Z = (const u16*)(ws + O_Z);
  const u16* ST = (const u16*)(ws + O_ST);
  u16* OH = (u16*)(ws + O_OH);
  const int chunk = item & 127, h = (item >> 7) & 3, b = item >> 9;
  const int tid = tidx(), k = tid & 63, w = tid >> 6, lane = tid & 63, l31 = lane & 31, hh = lane >> 5;
  const size_t tok0 = (size_t)b * 8192 + chunk * 64;
  u16* Q1 = sm;
  u16* Q2 = sm + 64 * 72;
  u16* KT = sm + 2 * 64 * 72;
  u16* VT = sm + 3 * 64 * 72;
  float* tot = (float*)(sm + 4 * 64 * 72);
  float* ssum = tot + 256;
  const int vt = w >> 1, tt = w & 1;
  u16 zf[16], zb[16], qraw[16];
  {
    const u16* zc = Z + (tok0 + w * 16) * ZW + h * 64 + k;
    u16 vraw[16];
#pragma unroll
    for (int j = 0; j < 16; ++j) {
      vraw[j] = zc[(size_t)j * ZW + 1312];
      zf[j] = zc[(size_t)j * ZW + 1568];
      zb[j] = zc[(size_t)j * ZW + 1824];
      qraw[j] = zc[(size_t)j * ZW + 1056];
    }
    float vv[16];
#pragma unroll
    for (int j = 0; j < 16; ++j) vv[j] = bf2f(vraw[j]);
    *(uint4*)(VT + k * 72 + w * 16) = pack8(vv);
    *(uint4*)(VT + k * 72 + w * 16 + 8) = pack8(vv + 8);
  }
  bf16x8 stf[2][4];
#pragma unroll
  for (int d2 = 0; d2 < 2; ++d2) {
    const size_t sti = ((size_t)((b * 4 + h) * 2 + d2) * 128 + chunk) * 4096;
#pragma unroll
    for (int ks = 0; ks < 4; ++ks) stf[d2][ks] = *(const bf16x8*)(ST + sti + (vt * 32 + l31) * 64 + ks * 16 + hh * 8);
  }
  f32x16 O;
#pragma unroll
  for (int r = 0; r < 16; ++r) O[r] = 0.f;
#pragma unroll
  for (int dir = 0; dir < 2; ++dir) {
    float cum[16], kk[16], total;
    if (dir) hgrn_gates(zb, hgrn_lb(p, l, 1, h * 64 + k), 1, w, k, tot, cum, kk, total);
    else hgrn_gates(zf, hgrn_lb(p, l, 0, h * 64 + k), 0, w, k, tot, cum, kk, total);
    const float ref = 0.5f * total;
#pragma unroll
    for (int j = 0; j < 16; ++j) {
      const int t = w * 16 + j;
      const float q = bf2f(qraw[j]);
      Q1[t * 72 + k] = f2bf(q * __expf(cum[j] - ref));
      Q2[t * 72 + k] = f2bf(q * __expf(cum[j]));
      KT[t * 72 + k] = f2bf(kk[j] * __expf(ref - cum[j]));
    }
    __syncthreads();
#pragma unroll
    for (int sb = 0; sb < 2; ++sb) {
      f32x16 sc;
#pragma unroll
      for (int r = 0; r < 16; ++r) sc[r] = 0.f;
#pragma unroll
      for (int ks = 0; ks < 4; ++ks) {
        const bf16x8 a = *(const bf16x8*)(KT + (sb * 32 + l31) * 72 + ks * 16 + hh * 8);
        const bf16x8 bq = *(const bf16x8*)(Q1 + (tt * 32 + l31) * 72 + ks * 16 + hh * 8);
        sc = MFMA(a, bq, sc);
      }
      const int tcol = tt * 32 + l31;
      float pm[16];
#pragma unroll
      for (int r = 0; r < 16; ++r) {
        const int srow = sb * 32 + crow(r, hh);
        const bool keep = dir ? (srow >= tcol) : (srow <= tcol);
        pm[r] = keep ? sc[r] : 0.f;
      }
#pragma unroll
      for (int ts = 0; ts < 2; ++ts) {
        const uint4 pk = pack8(pm + 8 * ts);
        const bf16x8 pf = __builtin_bit_cast(bf16x8, pk);
        const u16* vp = VT + (vt * 32 + l31) * 72 + sb * 32 + ts * 16 + hh * 4;
        const s16x4 lo = *(const s16x4*)vp;
        const s16x4 hi = *(const s16x4*)(vp + 8);
        const bf16x8 vf = __builtin_shufflevector(lo, hi, 0, 1, 2, 3, 4, 5, 6, 7);
        O = MFMA(vf, pf, O);
      }
    }
#pragma unroll
    for (int ks = 0; ks < 4; ++ks) {
      const bf16x8 bq = *(const bf16x8*)(Q2 + (tt * 32 + l31) * 72 + ks * 16 + hh * 8);
      O = MFMA(stf[dir][ks], bq, O);
    }
    __syncthreads();
  }
  float ss = 0.f;
#pragma unroll
  for (int r = 0; r < 16; ++r) ss += O[r] * O[r];
  ss += __shfl_xor(ss, 32);
  if (hh == 0) ssum[vt * 64 + tt * 32 + l31] = ss;
  __syncthreads();
  const float rr = rsqrtf((ssum[tt * 32 + l31] + ssum[64 + tt * 32 + l31]) * (1.f / 64.f) + EPS);
  const size_t tok = tok0 + tt * 32 + l31;
  const float* gon = p.in[17] + l * 64;
  uint2 hgv[4];
  float4 gv4[4];
#pragma unroll
  for (int i = 0; i < 4; ++i) {
    const int v0 = vt * 32 + 8 * i + 4 * hh;
    hgv[i] = *(const uint2*)(Z + tok * ZW + 2080 + h * 64 + v0);
    gv4[i] = *(const float4*)(gon + v0);
  }
#pragma unroll
  for (int i = 0; i < 4; ++i) {
    const int v0 = vt * 32 + 8 * i + 4 * hh;
    const uint2 hg = hgv[i];
    const float g0 = sigmoid_fast(bflo(hg.x)), g1 = sigmoid_fast(bfhi(hg.x));
    const float g2 = sigmoid_fast(bflo(hg.y)), g3 = sigmoid_fast(bfhi(hg.y));
    uint2 o;
    o.x = pack2(O[4 * i + 0] * rr * gv4[i].x * g0, O[4 * i + 1] * rr * gv4[i].y * g1);
    o.y = pack2(O[4 * i + 2] * rr * gv4[i].z * g2, O[4 * i + 3] * rr * gv4[i].w * g3);
    *(uint2*)(OH + tok * 256 + h * 64 + v0) = o;
  }
  __syncthreads();
}

DI void prep_diff(const Params& p, int l, int blk) {
  char* ws = lws(p.ws);
  const u16* Z = (const u16*)(ws + O_Z);
  const float* rc = (const float*)(ws + O_RC);
  const float* rs = (const float*)(ws + O_RS);
#pragma unroll
  for (int g = 0; g < 4; ++g) {
    const int isk = g >> 1;
    const int idx = tidx() + 256 * (g & 1);
    const int tl = idx >> 3, j = idx & 7;
    const int tok = blk * 64 + tl, b = tok >> 13, s = tok & 8191;
    const u16* src = Z + (size_t)tok * ZW + (isk ? 800 : 544) + j * 32;
    const float* gain = p.in[isk ? 10 : 9] + l * 32;
    float x[32];
#pragma unroll
    for (int i = 0; i < 4; ++i) unpack8(*(const uint4*)(src + 8 * i), x + 8 * i);
    float ss = 0.f;
#pragma unroll
    for (int i = 0; i < 32; ++i) ss += x[i] * x[i];
    const float r = rsqrtf(ss * (1.f / 32.f) + EPS);
#pragma unroll
    for (int i = 0; i < 32; ++i) x[i] = x[i] * r * gain[i];
    const float sc = isk ? 1.f : 0.17677669529663687f * LOG2E;
#pragma unroll
    for (int i = 0; i < 16; ++i) {
      const float c = rc[s * 16 + i], sn = rs[s * 16 + i];
      const float a = x[i], bb = x[i + 16];
      x[i] = (a * c - bb * sn) * sc;
      x[i + 16] = (a * sn + bb * c) * sc;
    }
    const int hd = j >> 1, mp = j & 1;
    u16* dst = (u16*)(ws + (isk ? O_KD : O_QD)) + ((((size_t)b * 4 + hd) * 2 + mp) * 8192 + s) * 32;
#pragma unroll
    for (int i = 0; i < 4; ++i) *(uint4*)(dst + 8 * i) = pack8(x + 8 * i);
  }
}

DI void prep_mla(const Params& p, int l, int blk) {
  char* ws = p.ws;
  const u16* Z = (const u16*)(ws + O_Z);
  const float* rc = (const float*)(ws + O_RC);
  const float* rs = (const float*)(ws + O_RS);
  const int tl = tidx() >> 2, hd = tidx() & 3;
  const int tok = blk * 64 + tl, b = tok >> 13, s = tok & 8191;
#pragma unroll 1
  for (int isk = 0; isk < 2; ++isk) {
    const u16* src0 = isk ? (const u16*)(ws + O_KN) + (size_t)tok * 256 + hd * 64 : (const u16*)(ws + O_QRAW) + (size_t)tok * 384 + hd * 96;
    const u16* src1 = isk ? Z + (size_t)tok * ZW + 512 : src0 + 64;
    const float* gain = p.in[isk ? 8 : 7] + l * 96;
    float ss = 0.f;
#pragma unroll
    for (int i = 0; i < 8; ++i) {
      float x[8]; unpack8(*(const uint4*)(src0 + 8 * i), x);
#pragma unroll
      for (int j = 0; j < 8; ++j) ss += x[j] * x[j];
    }
#pragma unroll
    for (int i = 0; i < 4; ++i) {
      float x[8]; unpack8(*(const uint4*)(src1 + 8 * i), x);
#pragma unroll
      for (int j = 0; j < 8; ++j) ss += x[j] * x[j];
    }
    const float r = rsqrtf(ss * (1.f / 96.f) + EPS);
    const float sc = isk ? 1.f : 0.10206207261596575f * LOG2E;
    const float rsc = r * sc;
    u16* dst = (u16*)(ws + (isk ? O_KM : O_QM)) + (((size_t)b * 4 + hd) * 8192 + s) * 96;
#pragma unroll
    for (int ib = 0; ib < 2; ++ib) {
      uint4 raw[4];
      float4 gq[8];
#pragma unroll
      for (int q = 0; q < 4; ++q) raw[q] = *(const uint4*)(src0 + 8 * (4 * ib + q));
#pragma unroll
      for (int q = 0; q < 8; ++q) gq[q] = *(const float4*)(gain + 32 * ib + 4 * q);
#pragma unroll
      for (int q = 0; q < 4; ++q) {
        const int i = 4 * ib + q;
        float x[8]; unpack8(raw[q], x);
        x[0] *= rsc * gq[2 * q].x; x[1] *= rsc * gq[2 * q].y; x[2] *= rsc * gq[2 * q].z; x[3] *= rsc * gq[2 * q].w;
        x[4] *= rsc * gq[2 * q + 1].x; x[5] *= rsc * gq[2 * q + 1].y; x[6] *= rsc * gq[2 * q + 1].z; x[7] *= rsc * gq[2 * q + 1].w;
        *(uint4*)(dst + 8 * i) = pack8(x);
      }
    }
    {
      uint4 raw[4];
      float4 gq[8], cq[4], sq[4];
#pragma unroll
      for (int q = 0; q < 4; ++q) raw[q] = *(const uint4*)(src1 + 8 * q);
#pragma unroll
      for (int q = 0; q < 8; ++q) gq[q] = *(const float4*)(gain + 64 + 4 * q);
#pragma unroll
      for (int q = 0; q < 4; ++q) { cq[q] = *(const float4*)(rc + s * 16 + 4 * q); sq[q] = *(const float4*)(rs + s * 16 + 4 * q); }
      const float* gqf = (const float*)gq;
      const float* cqf = (const float*)cq;
      const float* sqf = (const float*)sq;
#pragma unroll
      for (int i = 0; i < 2; ++i) {
        float xa[8], xb[8];
        unpack8(raw[i], xa);
        unpack8(raw[2 + i], xb);
#pragma unroll
        for (int j = 0; j < 8; ++j) {
          const int fi = 8 * i + j;
          const float c = cqf[fi], sn = sqf[fi];
          const float a = xa[j] * rsc * gqf[fi], bb = xb[j] * rsc * gqf[16 + fi];
          xa[j] = a * c - bb * sn;
          xb[j] = a * sn + bb * c;
        }
        *(uint4*)(dst + 64 + 8 * i) = pack8(xa);
        *(uint4*)(dst + 80 + 8 * i) = pack8(xb);
      }
    }
  }
}

#define SEG_LOOP(it, base, n) \
  _Pragma("unroll 1") for (int it = (int)((bidx() + VGRID - ((base) % VGRID)) % VGRID); it < (n); it += VGRID)

DI void ph_c(const Params& p, int l, u16* sm) {
  char* ws = lws(p.ws);
  const u16* Z = (const u16*)(ws + O_Z);
  float* rstd = (float*)((char*)sm + 73728);
  SEG_LOOP(it, 0, 768) {
    const int tn = it % 3, tm = it / 3;
    f32x16 acc[2][2]; zero_acc<2>(acc);
    const u16* A = Z + (size_t)tm * 128 * ZW;
    block_rstd(A, ZW, 384, rstd);
    gemm_ml<2, 2>(A, ZW, (const u16*)(ws + O_WUQ) + (size_t)tn * 128 * 384, 384, 384, acc, sm);
    u16* dst = (u16*)(ws + O_QRAW);
    epi<2>(acc, [&](int m, int n, float v) { dst[(size_t)(tm * 128 + m) * 384 + tn * 128 + n] = f2bf(v * rstd[m]); });
    __syncthreads();
  }
  SEG_LOOP(it, 768, 512) {
    const int tn = it & 1, tm = it >> 1;
    f32x16 acc[2][2]; zero_acc<2>(acc);
    const u16* A = Z + (size_t)tm * 128 * ZW + 384;
    block_rstd(A, ZW, 128, rstd);
    gemm_ml<2, 2>(A, ZW, (const u16*)(ws + O_WKN) + (size_t)tn * 128 * 128, 128, 128, acc, sm);
    u16* dst = (u16*)(ws + O_KN);
    epi<2>(acc, [&](int m, int n, float v) { dst[(size_t)(tm * 128 + m) * 256 + tn * 128 + n] = f2bf(v * rstd[m]); });
    __syncthreads();
  }
  SEG_LOOP(it, 1280, 512) {
    const int tmf = it & 1, nt = it >> 1;
    f32x16 acc[2][2]; zero_acc<2>(acc);
    const u16* B = Z + (size_t)nt * 128 * ZW + 384;
    block_rstd(B, ZW, 128, rstd);
    gemm_ml<2, 2>((const u16*)(ws + O_WV) + (size_t)tmf * 128 * 128, 128, B, ZW, 128, acc, sm);
    u16* dst = (u16*)(ws + O_VMT);
    epi<2>(acc, [&](int m, int n, float v) { dst[(size_t)(tmf * 128 + m) * T + nt * 128 + n] = f2bf(v * rstd[n]); });
    __syncthreads();
  }
  SEG_LOOP(it, 1792, 1024) {
    const int tmE = it & 1, tn = it >> 1;
    f32x16 acc[2][2]; zero_acc<2>(acc);
    gemm_ml<2, 2>((const u16*)(ws + O_E1) + (size_t)tmE * 128 * 128, 128, (const u16*)(ws + O_UT) + (size_t)tn * 128 * 128, 128, 128, acc, sm);
    u16* GT = (u16*)(ws + O_GT);
    const int lane = tidx() & 63, wave = tidx() >> 6, l31 = lane & 31, hh = lane >> 5, wm = wave >> 1, wn = wave & 1;
#pragma unroll
    for (int nt = 0; nt < 2; ++nt)
#pragma unroll
      for (int r = 0; r < 16; ++r) {
        const float re = acc[0][nt][r], im = acc[1][nt][r];
        const int p1 = tmE * 64 + wm * 32 + crow(r, hh);
        const int n = tn * 128 + wn * 64 + nt * 32 + l31;
        const int b = n >> 14, c = (n >> 6) & 255, s2 = n & 63;
        const float fr = (float)(s2 * p1) * (1.f / 8192.f);
        const float cs = __builtin_amdgcn_cosf(fr), sn = __builtin_amdgcn_sinf(fr);
        const float re2 = re * cs + im * sn, im2 = im * cs - re * sn;
        *(unsigned*)(GT + ((((size_t)(b * 128 + p1)) * 256 + c) * 64 + s2) * 2) = pack2(re2, im2);
      }
  }
  SEG_LOOP(it, 2816, 512) { prep_diff(p, l, it); }
  {
    const int g_ = VGRID;
    int it = (int)((bidx() + g_ - (3328 % g_)) % g_);
    u16 zc_[16], vc_[16];
    if (it < 4096) hgrn_h1_load(p, it, zc_, vc_);
#pragma unroll 1
    for (; it < 4096; it += g_) {
      u16 zn_[16], vn_[16];
      const int nx = it + g_;
      hgrn_h1_load(p, nx < 4096 ? nx : it, zn_, vn_);
      hgrn_h1(p, l, it, sm, zc_, vc_);
#pragma unroll
      for (int j = 0; j < 16; ++j) { zc_[j] = zn_[j]; vc_[j] = vn_[j]; }
    }
  }
}

DI void ph_d(const Params& p, int l, u16* sm) {
  char* ws = lws(p.ws);
  SEG_LOOP(tn, 0, 1024) {
    f32x16 acc[2][2]; zero_acc<2>(acc);
    gemm_ml<2, 2>((const u16*)(ws + O_E2), 128, (const u16*)(ws + O_GT) + (size_t)tn * 128 * 128, 128, 128, acc, sm);
    u16* OF = (u16*)(ws + O_OF);
    epi<2>(acc, [&](int m, int n, float v) {
      const int sel = m >> 6, p2 = m & 63;
      const int nn = tn * 128 + n;
      const int b = nn >> 15, p1 = (nn >> 8) & 127, c = nn & 255;
      const size_t tok = (size_t)b * 8192 + p1 + 128 * p2;
      OF[tok * 512 + sel * 256 + c] = f2bf(v);
    });
  }
  SEG_LOOP(it, 1024, 512) { prep_mla(p, l, it); }
  hgrn_h2(p);
}

template <int DK, int NMAP>
DI void attn_core(const u16* __restrict__ Qb, const u16* __restrict__ Kb, long mapstride, const u16* __restrict__ VTb, int q0,
                  f32x16 (&O)[NMAP][2], float (&ls)[NMAP], u16* sm) {
  constexpr int KS = DK / 16, KROW = DK + 8, KT_E = NMAP * 128 * KROW, VROW = 136, BUF = KT_E + 64 * VROW;
  constexpr int CPR = DK / 8;
  constexpr int CHM = 128 * CPR;
  constexpr int NKS = NMAP * CHM / 512;
  const int tid = rtid(), lane = tid & 63, wave = tid >> 6, l31 = lane & 31, hh = lane >> 5;
  bf16x8 qf[NMAP][KS];
  {
    const int query = q0 + wave * 32 + l31;
#pragma unroll
    for (int mp = 0; mp < NMAP; ++mp)
#pragma unroll
      for (int ks = 0; ks < KS; ++ks) qf[mp][ks] = *(const bf16x8*)(Qb + mp * mapstride + (long)query * DK + ks * 16 + hh * 8);
#pragma unroll
    for (int mp = 0; mp < NMAP; ++mp)
#pragma unroll
      for (int ks = 0; ks < KS; ++ks) asm volatile("" : "+v"(qf[mp][ks]));
  }
#pragma unroll
  for (int mp = 0; mp < NMAP; ++mp) {
    ls[mp] = 0.f;
#pragma unroll
    for (int dt = 0; dt < 2; ++dt)
#pragma unroll
      for (int r = 0; r < 16; ++r) O[mp][dt][r] = 0.f;
  }
  struct Stg { u32x4 k0, k1, k2, v0, v1; };
  Stg r0;
  const int g0 = tid, g1 = tid + 512, g2 = (NKS > 2) ? tid + 1024 : tid;
  const u16* gk0 = Kb + (g0 / CHM) * mapstride + (g0 % CHM) * 8;
  const u16* gk1 = Kb + (g1 / CHM) * mapstride + (g1 % CHM) * 8;
  const u16* gk2 = Kb + (g2 / CHM) * mapstride + (g2 % CHM) * 8;
  const int lk0 = ((g0 / CHM) * 128 + (g0 % CHM) / CPR) * KROW + ((g0 % CHM) % CPR) * 8;
  const int lk1 = ((g1 / CHM) * 128 + (g1 % CHM) / CPR) * KROW + ((g1 % CHM) % CPR) * 8;
  const int lk2 = ((g2 / CHM) * 128 + (g2 % CHM) / CPR) * KROW + ((g2 % CHM) % CPR) * 8;
  const u16* gv0 = VTb + (long)(g0 >> 4) * T + (g0 & 15) * 8;
  const u16* gv1 = VTb + (long)(g1 >> 4) * T + (g1 & 15) * 8;
  const int lv0 = (g0 >> 4) * VROW + ((g0 & 15) >> 1) * 16 + (g0 & 1) * 4;
  const int lv1 = (g1 >> 4) * VROW + ((g1 & 15) >> 1) * 16 + (g1 & 1) * 4;
#define AGL(R, kt_)                                              \
  {                                                              \
    const long ko = (long)(kt_) * 128 * DK;                      \
    R.k0 = *(const u32x4*)(gk0 + ko);                            \
    R.k1 = *(const u32x4*)(gk1 + ko);                            \
    if (NKS > 2) R.k2 = *(const u32x4*)(gk2 + ko);               \
    R.v0 = *(const u32x4*)(gv0 + (kt_) * 128);                   \
    R.v1 = *(const u32x4*)(gv1 + (kt_) * 128);                   \
  }
#define ASW(R, buf_)                                             \
  {                                                              \
    u16* ks_ = sm + (buf_) * BUF;                                \
    u16* vs_ = ks_ + KT_E;                                       \
    *(u32x4*)(ks_ + lk0) = R.k0;                                 \
    *(u32x4*)(ks_ + lk1) = R.k1;                                 \
    if (NKS > 2) *(u32x4*)(ks_ + lk2) = R.k2;                    \
    *(uint2*)(vs_ + lv0) = make_uint2(R.v0[0], R.v0[1]);         \
    *(uint2*)(vs_ + lv0 + 8) = make_uint2(R.v0[2], R.v0[3]);     \
    *(uint2*)(vs_ + lv1) = make_uint2(R.v1[0], R.v1[1]);         \
    *(uint2*)(vs_ + lv1 + 8) = make_uint2(R.v1[2], R.v1[3]);     \
  }
  auto compute = [&](int buf) {
    const u16* ks_ = sm + buf * BUF;
    const u16* vs_ = ks_ + KT_E;
    auto qk = [&](int u, f32x16& s) {
      const int sb = u / NMAP, mp = u % NMAP;
#pragma unroll
      for (int r = 0; r < 16; ++r) s[r] = 0.f;
#pragma unroll
      for (int ks = 0; ks < KS; ++ks) {
        const bf16x8 kf = *(const bf16x8*)(ks_ + (mp * 128 + sb * 32 + l31) * KROW + ks * 16 + hh * 8);
        s = MFMA(kf, qf[mp][ks], s);
      }
    };
    auto smpv = [&](int u, f32x16& s) {
      const int sb = u / NMAP, mp = u % NMAP;
      float pr[16];
      float a0 = 0.f, a1 = 0.f, a2 = 0.f, a3 = 0.f;
#pragma unroll
      for (int r = 0; r < 16; r += 4) {
        pr[r] = __builtin_amdgcn_exp2f(s[r]); a0 += pr[r];
        pr[r + 1] = __builtin_amdgcn_exp2f(s[r + 1]); a1 += pr[r + 1];
        pr[r + 2] = __builtin_amdgcn_exp2f(s[r + 2]); a2 += pr[r + 2];
        pr[r + 3] = __builtin_amdgcn_exp2f(s[r + 3]); a3 += pr[r + 3];
      }
      ls[mp] += (a0 + a1) + (a2 + a3);
      bf16x8 pf[2];
      pf[0] = __builtin_bit_cast(bf16x8, pack8(pr));
      pf[1] = __builtin_bit_cast(bf16x8, pack8(pr + 8));
#pragma unroll
      for (int ts = 0; ts < 2; ++ts)
#pragma unroll
        for (int dt = 0; dt < 2; ++dt) {
          const bf16x8 vf = *(const bf16x8*)(vs_ + (dt * 32 + l31) * VROW + sb * 32 + ts * 16 + hh * 8);
          O[mp][dt] = MFMA(vf, pf[ts], O[mp][dt]);
        }
    };
    f32x16 sA, sB;
    qk(0, sA);
    if (NMAP == 1) {
#pragma unroll
      for (int u = 0; u < 4; ++u) {
        if (u + 1 < 4) qk(u + 1, (u & 1) ? sA : sB);
        smpv(u, (u & 1) ? sB : sA);
      }
    } else {
#pragma unroll 1
      for (int sb = 0; sb < 4; ++sb) {
        qk(sb * NMAP + 1, sB);
        smpv(sb * NMAP, sA);
        qk(((sb + 1) & 3) * NMAP, sA);
        smpv(sb * NMAP + 1, sB);
      }
    }
  };
  constexpr int NKT = SEQ / 128;
  AGL(r0, 0);
  ASW(r0, 0);
  __syncthreads();
  if (wave >= 4) __builtin_amdgcn_s_setprio(1);
#pragma unroll 1
  for (int kt = 0; kt < NKT; ++kt) {
    const int buf = kt & 1;
    if (kt + 1 < NKT) AGL(r0, kt + 1);
    compute(buf);
    if (kt + 1 < NKT) ASW(r0, buf ^ 1);
    __syncthreads();
  }
#undef AGL
#undef ASW
  __builtin_amdgcn_s_setprio(0);
#pragma unroll
  for (int mp = 0; mp < NMAP; ++mp) ls[mp] += __shfl_xor(ls[mp], 32);
}

DI void attn_mla(const Params& p, int l, int id, u16* sm) {
  char* ws = lws(p.ws);
  const int lane = rtid() & 63, wave = rtid() >> 6, l31 = lane & 31, hh = lane >> 5;
  const int bh = id >> 5, qb = id & 31, b = bh >> 2, hd = bh & 3;
  const int q0 = qb * 256;
  const size_t tok = (size_t)b * 8192 + q0 + wave * 32 + l31;
  f32x16 O[1][2];
  float ls[1];
  attn_core<96, 1>((const u16*)(ws + O_QM) + (size_t)bh * 8192 * 96, (const u16*)(ws + O_KM) + (size_t)bh * 8192 * 96, 0,
                   (const u16*)(ws + O_VMT) + (size_t)(hd * 64) * T + (size_t)b * 8192, q0, O, ls, sm);
  const float inv = 1.f / ls[0];
  u16* dst = (u16*)(ws + O_OM) + tok * 256 + hd * 64;
#pragma unroll
  for (int dt = 0; dt < 2; ++dt)
#pragma unroll
    for (int i = 0; i < 4; ++i) {
      uint2 o;
      o.x = pack2(O[0][dt][4 * i] * inv, O[0][dt][4 * i + 1] * inv);
      o.y = pack2(O[0][dt][4 * i + 2] * inv, O[0][dt][4 * i + 3] * inv);
      *(uint2*)(dst + dt * 32 + 8 * i + 4 * hh) = o;
    }
}

DI void attn_diff(const Params& p, int l, int id, u16* sm) {
  char* ws = lws(p.ws);
  const int lane = rtid() & 63, wave = rtid() >> 6, l31 = lane & 31, hh = lane >> 5;
  const int bh = id >> 5, qb = id & 31, b = bh >> 2, hd = bh & 3;
  const int q0 = qb * 256;
  const size_t tok = (size_t)b * 8192 + q0 + wave * 32 + l31;
  f32x16 O[2][2];
  float ls[2];
  attn_core<32, 2>((const u16*)(ws + O_QD) + (size_t)bh * 2 * 8192 * 32, (const u16*)(ws + O_KD) + (size_t)bh * 2 * 8192 * 32,
                   8192 * 32, (const u16*)(ws + O_VDT) + (size_t)(hd * 64) * T + (size_t)b * 8192, q0, O, ls, sm);
  float d1 = 0.f, d2 = 0.f;
  for (int i = 0; i < 32; ++i) {
    d1 += p.in[11][l * 32 + i] * p.in[12][l * 32 + i];
    d2 += p.in[13][l * 32 + i] * p.in[14][l * 32 + i];
  }
  const float lam_init = 0.8f - 0.6f * expf(-0.3f * (float)l);
  const float lam = expf(d1) - expf(d2) + lam_init;
  const float i1 = 1.f / ls[0], i2 = lam / ls[1];
  float ss = 0.f;
#pragma unroll
  for (int dt = 0; dt < 2; ++dt)
#pragma unroll
    for (int r = 0; r < 16; ++r) {
      const float v = O[0][dt][r] * i1 - O[1][dt][r] * i2;
      O[0][dt][r] = v;
      ss += v * v;
    }
  ss += __shfl_xor(ss, 32);
  const float rr = rsqrtf(ss * (1.f / 64.f) + EPS) * (1.f - lam_init);
  const float* gs = p.in[15] + l * 64;
  u16* dst = (u16*)(ws + O_OD) + tok * 256 + hd * 64;
  float4 gsv[2][4];
#pragma unroll
  for (int dt = 0; dt < 2; ++dt)
#pragma unroll
    for (int i = 0; i < 4; ++i) gsv[dt][i] = *(const float4*)(gs + dt * 32 + 8 * i + 4 * hh);
#pragma unroll
  for (int dt = 0; dt < 2; ++dt)
#pragma unroll
    for (int i = 0; i < 4; ++i) {
      const int d0 = dt * 32 + 8 * i + 4 * hh;
      uint2 o;
      o.x = pack2(O[0][dt][4 * i] * rr * gsv[dt][i].x, O[0][dt][4 * i + 1] * rr * gsv[dt][i].y);
      o.y = pack2(O[0][dt][4 * i + 2] * rr * gsv[dt][i].z, O[0][dt][4 * i + 3] * rr * gsv[dt][i].w);
      *(uint2*)(dst + d0) = o;
    }
}

DI void ph_e(const Params& p, int l, u16* sm, u16* sm_all) {
#ifndef NO_MLA
#pragma unroll 1
  for (int it = rbid(); it < 512; it += (int)gridDim.x) {
    const int xcd = it & 7, q = it >> 3, grp = q >> 5, j = q & 31;
    attn_mla(p, l, (grp * 8 + xcd) * 32 + j, sm_all);
  }
#endif
#ifndef NO_DIFF
#pragma unroll 1
  for (int it = rbid(); it < 512; it += (int)gridDim.x) {
    const int xcd = it & 7, q = it >> 3, grp = q >> 5, j = q & 31;
    attn_diff(p, l, (grp * 8 + xcd) * 32 + j, sm_all);
  }
#endif
#ifndef NO_H3
  SEG_LOOP(it, 0, 2048) { hgrn_h3(p, l, it, sm); }
#endif
}

DI void ph_merge(const Params& p, u16* sm) {
  char* ws = lws(p.ws);
  const u16* G = (const u16*)(ws + O_G);
  u16* MG = (u16*)(ws + O_MG);
  const int lane = tidx() & 63, wave = tidx() >> 6, l31 = lane & 31, hh = lane >> 5, wm = wave >> 1, wn = wave & 1;
#pragma unroll 1
  for (int it = bidx(); it < 256 * 8; it += VGRID) {
    const int tn = it & 7, tm = it >> 3;
    f32x16 mg[2][2];
    zero_acc<2>(mg);
#pragma unroll 1
    for (int n = 0; n < 4; ++n) {
      f32x16 ab[2][2];
      zero_acc<2>(ab);
      const size_t oa = n == 0 ? O_OM : (n == 1 ? O_OF : (n == 2 ? O_OD : O_OH));
      const size_t ob = n == 0 ? O_WB0 : (n == 1 ? O_WB1 : (n == 2 ? O_WB2 : O_WB3));
      const int kn = n == 1 ? 512 : 256;
      gemm_ml<2, 2>((const u16*)(ws + oa) + (size_t)tm * 128 * kn, kn, (const u16*)(ws + ob) + (size_t)tn * 128 * kn, kn, kn, ab, sm);
      const u16* gp = G + (size_t)(tm * 128 + wm * 64 + 4 * hh) * 4096 + n * 1024 + tn * 128 + wn * 64 + l31;
#pragma unroll
      for (int mt = 0; mt < 2; ++mt)
#pragma unroll
        for (int nt = 0; nt < 2; ++nt)
#pragma unroll
          for (int r = 0; r < 16; ++r) {
            const float g = bf2f(gp[(size_t)(mt * 32 + (r & 3) + 8 * (r >> 2)) * 4096 + nt * 32]);
            mg[mt][nt][r] += g * ab[mt][nt][r];
          }
    }
    epi<2>(mg, [&](int m, int n, float v) { MG[(size_t)(tm * 128 + m) * 1024 + tn * 128 + n] = f2bf(v); });
  }
}

#define XB_TMO      128
#define XB_XCNT(j)  (256  + 64 * (j))
#define XB_XSUB(j)  (1280 + 64 * (j))
#define XB_XGEN(j)  (2304 + 64 * (j))
#define XB_TOP      3328
#define XB_TOPGEN   3392
#define XCD_BAR_WORDS 3456
#define XB_SPIN_CAP (1u << 18)
#define XLAS __attribute__((address_space(3)))

__device__ __forceinline__ unsigned xb_ld(unsigned* p)              { return __hip_atomic_load(p, __ATOMIC_RELAXED, __HIP_MEMORY_SCOPE_AGENT); }
__device__ __forceinline__ unsigned xb_add(unsigned* p, unsigned v) { return __hip_atomic_fetch_add(p, v, __ATOMIC_RELAXED, __HIP_MEMORY_SCOPE_AGENT); }
__device__ __forceinline__ unsigned xb_xcc_id() { return (unsigned)__builtin_amdgcn_s_getreg((3 << 11) | 20) & 0xFu; }
#define XB_SPIN(cond, bar) do { unsigned _sp = 0; while (cond) { __builtin_amdgcn_s_sleep(1); \
    if ((++_sp & 255u) == 0u) { if (xb_ld(&(bar)[XB_TMO])) break; if (_sp > XB_SPIN_CAP) { atomicAdd(&(bar)[XB_TMO], 1u); break; } } } } while (0)

struct XcdBarrier {
    unsigned* bar; unsigned x;
    volatile XLAS unsigned* st;
};

__device__ __forceinline__ XcdBarrier xcd_barrier_post(unsigned* bar, volatile XLAS unsigned* st) {
    XcdBarrier b; b.bar = bar; b.x = xb_xcc_id(); b.st = st;
    if (threadIdx.x == 0) (void)xb_add(&bar[XB_XCNT(b.x)], 1u);
    return b;
}
__device__ __forceinline__ void xcd_barrier_complete(unsigned* bar, unsigned x, unsigned& nloc, unsigned& nx) {
    const unsigned G = gridDim.x * gridDim.y * gridDim.z;
    unsigned sum, cnt, mine, sp = 0u;
    for (;;) {
        sum = 0u; cnt = 0u; mine = 0u;
#pragma unroll
        for (unsigned j = 0; j < 16; ++j) { const unsigned c = xb_ld(&bar[XB_XCNT(j)]); sum += c; cnt += (c > 0u) ? 1u : 0u; mine = (j == x) ? c : mine; }
        if (sum == G) break;
        __builtin_amdgcn_s_sleep(1);
        if ((++sp & 255u) == 0u) { if (xb_ld(&bar[XB_TMO])) break; if (sp > XB_SPIN_CAP) { atomicAdd(&bar[XB_TMO], 1u); break; } }
    }
    nloc = mine > 0u ? mine : 1u; nx = cnt > 0u ? cnt : 1u;
}

__device__ __forceinline__ void xcd_barrier(const XcdBarrier& b) {
    asm volatile("s_waitcnt vmcnt(0)" ::: "memory");
    __syncthreads();
    if (threadIdx.x == 0) {
        unsigned* bar = b.bar;
        __builtin_amdgcn_s_waitcnt(0);
        unsigned nloc = b.st[0], nx = b.st[1];
        if (nloc == 0u) { xcd_barrier_complete(bar, b.x, nloc, nx); b.st[0] = nloc; b.st[1] = nx; }
        const unsigned old = xb_add(&bar[XB_XSUB(b.x)], 1u);
        const unsigned gen = old / nloc;
        if (old + 1u == (gen + 1u) * nloc) {
            __builtin_amdgcn_fence(__ATOMIC_RELEASE, "agent");
            asm volatile("s_waitcnt vmcnt(0)" ::: "memory");
            const unsigned og = xb_add(&bar[XB_TOP], 1u);
            const unsigned tg = og / nx;
            if (og + 1u == (tg + 1u) * nx) xb_add(&bar[XB_TOPGEN], 1u);
            else XB_SPIN(xb_ld(&bar[XB_TOPGEN]) == tg, bar);
            __builtin_amdgcn_fence(__ATOMIC_ACQUIRE, "agent");
            xb_add(&bar[XB_XGEN(b.x)], 1u);
            asm volatile("s_waitcnt vmcnt(0)" ::: "memory");
        } else {
            XB_SPIN(xb_ld(&bar[XB_XGEN(b.x)]) == gen, bar);
            __builtin_amdgcn_fence(__ATOMIC_ACQUIRE, "agent");
            asm volatile("s_waitcnt vmcnt(0)" ::: "memory");
        }
    }
    __syncthreads();
}


constexpr int NPH = 11;
#ifndef LB_MIN
#define LB_MIN 2
#endif

template <bool COOP>
__global__ void __launch_bounds__(512, LB_MIN) mk(Params p, int ph_lo, int ph_hi) {
  __shared__ __attribute__((aligned(16))) u16 sm_all[SMEM_BYTES + 8];
  u16* sm = sm_all + __builtin_amdgcn_readfirstlane((int)(threadIdx.x >> 8)) * (SMEM_BYTES / 2);
#ifndef PROBE_MASK
#define PROBE_MASK 0
#endif
  int rr = 0;
  (void)rr;
  if (threadIdx.x == 0) *(uint4*)(sm_all + SMEM_BYTES) = make_uint4(0u, 0u, 0u, 0u);
  __syncthreads();
  XcdBarrier xb = xcd_barrier_post((unsigned*)(p.ws + O_BAR), (volatile XLAS unsigned*)(sm_all + SMEM_BYTES));
  for (int ph = ph_lo; ph < ph_hi; ++ph) {
    const int l = ph / NPH, s = ph % NPH;
    char* ws = lws(p.ws);
    const float* xin = l == 0 ? p.in[0] : p.out;
#ifndef ONLY_PHASE
#define ONLY_PHASE -1
#endif
#define PH_ON(x) (ONLY_PHASE < 0 || ONLY_PHASE == (x))
    switch (s) {
      case 0:
        if (!PH_ON(0)) break;
        ph_wprep(p, l);
        ph_rmsnorm(xin, p.in[1] + l * 1024, (u16*)(ws + O_H));
        break;
      case 1:
        if (PH_ON(1)) {
          run_gemm8(sm_all, (const u16*)(ws + O_H), (const u16*)(ws + O_WZ), T, 2560, 1024, EpiZ{(u16*)(ws + O_Z)});
          if ((int)gridDim.x == 256) {
            pg8::Gemm g;
            g.A = (const u16*)(ws + O_WF); g.Bt = (const u16*)(ws + O_H); g.M = 512; g.N = T; g.K = 1024;
            FeatOrder S;
            S.c = (int)blockIdx.x;
            pg8::gemm_phase<EpiFeat, FeatOrder, false>((PG8_LAS unsigned char*)sm_all, g, S, EpiFeat{(u16*)(ws + O_UT), (u16*)(ws + O_VDT)}, nullptr);
          } else {
            ph_inproj(p, sm);
          }
        }
        break;
      case 2: if (PH_ON(2)) ph_c(p, l, sm); break;
      case 3: if (PH_ON(3)) ph_d(p, l, sm); break;
      case 4: if (PH_ON(4)) ph_e(p, l, sm, sm_all); break;
      case 5: if (PH_ON(5)) run_gemm8(sm_all, (const u16*)(ws + O_H), (const u16*)(ws + O_WG), T, 4096, 1024, EpiSig{(u16*)(ws + O_G)}); break;
      case 6:
        if (PH_ON(6)) {
          const u16* Gb = (const u16*)(ws + O_G);
          u16* MGb = (u16*)(ws + O_MG);
#pragma unroll 1
          for (int n = 0; n < 4; ++n) {
            const size_t oa = n == 0 ? O_OM : (n == 1 ? O_OF : (n == 2 ? O_OD : O_OH));
            const size_t ob = n == 0 ? O_WB0 : (n == 1 ? O_WB1 : (n == 2 ? O_WB2 : O_WB3));
            run_gemm8(sm_all, (const u16*)(ws + oa), (const u16*)(ws + ob), T, 1024, n == 1 ? 512 : 256, EpiMrg{Gb + n * 1024, MGb, n == 0});
          }
        }
        break;
      case 7: if (PH_ON(7)) run_gemm8(sm_all, (const u16*)(ws + O_MG), (const u16*)(ws + O_WO), T, 1024, 1024, EpiRes{xin, p.out}); break;
      case 8: if (PH_ON(8)) ph_rmsnorm(p.out, p.in[20] + l * 1024, (u16*)(ws + O_H)); break;
      case 9: if (PH_ON(9)) run_gemm8(sm_all, (const u16*)(ws + O_H), (const u16*)(ws + O_WGU), T, 5632, 1024, EpiSwi{(u16*)(ws + O_ACT)}); break;
      case 10: if (PH_ON(10)) run_gemm8(sm_all, (const u16*)(ws + O_ACT), (const u16*)(ws + O_WD), T, 1024, DFF, EpiRes{p.out, p.out}); break;
    }
    if (COOP) {
      if (ph + 1 < ph_hi) {
        if (ph_hi > 100000) cg::this_grid().sync();
        xcd_barrier(xb);
      }
    }
#if PROBE_MASK
    if (COOP && rr == 0 && ph < NPH && ((PROBE_MASK >> ph) & 1)) { rr = 1; --ph; } else rr = 0;
#endif
  }
}

extern "C" void kernel_launch(void* const* d_in, const int* in_sizes, int n_in, void* d_out, int out_size, void* d_ws,
                              size_t ws_size, hipStream_t stream) {
  Params p{};
  for (int i = 0; i < 23; ++i) p.in[i] = (const float*)d_in[i];
  p.out = (float*)d_out;
  p.ws = (char*)d_ws;
  if (ws_size < O_END2) fprintf(stderr, "workspace too small: %zu < %zu\n", ws_size, (size_t)O_END2);
  hipMemsetAsync((char*)d_ws + O_BAR, 0, 16384, stream);
  static int grid_blocks = 0;
  if (!grid_blocks) {
    int dev = 0, cus = 0, per_cu = 0;
    hipGetDevice(&dev);
    hipDeviceGetAttribute(&cus, hipDeviceAttributeMultiprocessorCount, dev);
#if MK_ONE_LAUNCH
    hipOccupancyMaxActiveBlocksPerMultiprocessor(&per_cu, mk<true>, 512, 0);
#else
    hipOccupancyMaxActiveBlocksPerMultiprocessor(&per_cu, mk<false>, 512, 0);
#endif
    if (per_cu < 1) per_cu = 1;
    if (per_cu > 1) per_cu = 1;
    grid_blocks = cus * per_cu;
  }
#if MK_ONE_LAUNCH
  int lo = 0, hi = 2 * NPH;
  void* args[] = {&p, &lo, &hi};
  hipError_t e = hipLaunchCooperativeKernel((void*)mk<true>, dim3(grid_blocks), dim3(512), args, 0, stream);
  if (e != hipSuccess) fprintf(stderr, "cooperative launch failed: %s (grid %d)\n", hipGetErrorString(e), grid_blocks);
#else
  for (int ph = 0; ph < 2 * NPH; ++ph) mk<false><<<grid_blocks, 512, 0, stream>>>(p, ph, ph + 1);
#endif
}
```

```cpp
#include <hip/hip_runtime.h>
#include <hip/hip_cooperative_groups.h>
#include <cstdio>
namespace cg = cooperative_groups;

#ifndef MK_ONE_LAUNCH
#define MK_ONE_LAUNCH 1
#endif

#define DI __device__ __forceinline__
typedef unsigned short u16;
typedef __bf16 bf2_t __attribute__((ext_vector_type(2)));
typedef float f2_t __attribute__((ext_vector_type(2)));
using bf16x8 = __attribute__((ext_vector_type(8))) short;
using s16x4 = __attribute__((ext_vector_type(4))) short;
using f32x16 = __attribute__((ext_vector_type(16))) float;
using u32x4 = __attribute__((ext_vector_type(4))) unsigned;
using f32x4_t = __attribute__((ext_vector_type(4))) float;
#define MFMA(a, b, c) __builtin_amdgcn_mfma_f32_32x32x16_bf16((a), (b), (c), 0, 0, 0)

constexpr int T = 32768, SEQ = 8192, ZW = 2336, INW = 6944, DFF = 2816;
constexpr float EPS = 1e-6f;
constexpr float LOG2E = 1.4426950408889634f;

constexpr size_t O_WZ = 0;
constexpr size_t O_WF = O_WZ + 2560ull * 1024 * 2;
constexpr size_t O_WG = O_WF + 512ull * 1024 * 2;
constexpr size_t O_WUQ = O_WG + 4096ull * 1024 * 2;
constexpr size_t O_WKN = O_WUQ + 384ull * 384 * 2;
constexpr size_t O_WV = O_WKN + 256ull * 128 * 2;
constexpr size_t O_WB0 = O_WV + 256ull * 128 * 2;
constexpr size_t O_WB1 = O_WB0 + 1024ull * 256 * 2;
constexpr size_t O_WB2 = O_WB1 + 1024ull * 512 * 2;
constexpr size_t O_WB3 = O_WB2 + 1024ull * 256 * 2;
constexpr size_t O_WO = O_WB3 + 1024ull * 256 * 2;
constexpr size_t O_WGU = O_WO + 1024ull * 1024 * 2;
constexpr size_t O_WD = O_WGU + 5632ull * 1024 * 2;
constexpr size_t O_RC = O_WD + 1024ull * 2816 * 2;
constexpr size_t O_RS = O_RC + 8192ull * 16 * 4;
constexpr size_t O_E1 = O_RS + 8192ull * 16 * 4;
constexpr size_t O_E2 = O_E1 + 256ull * 128 * 2;
constexpr size_t O_H = O_E2 + 128ull * 128 * 2;
constexpr size_t O_OF = O_H + (size_t)T * 1024 * 2;
constexpr size_t O_Z = O_OF + (size_t)T * 512 * 2;
constexpr size_t O_UT = O_Z + (size_t)T * ZW * 2;
constexpr size_t O_QM = O_UT;
constexpr size_t O_VDT = O_UT + (size_t)T * 384 * 2;
constexpr size_t O_VMT = O_VDT + (size_t)T * 256 * 2;
constexpr size_t O_KM = O_VMT + (size_t)T * 256 * 2;
constexpr size_t O_QD = O_KM + (size_t)T * 384 * 2;
constexpr size_t O_KD = O_QD + (size_t)T * 256 * 2;
constexpr size_t O_ST = O_KD + (size_t)T * 256 * 2;
constexpr size_t O_DEC = O_ST + 4096ull * 4096 * 2;
constexpr size_t O_GT = O_DEC + 4096ull * 64 * 4;
constexpr size_t O_OH = O_GT;
constexpr size_t O_QRAW = O_GT + (size_t)T * 512 * 2;
constexpr size_t O_OM = O_QRAW;
constexpr size_t O_KN = O_QRAW + (size_t)T * 384 * 2;
constexpr size_t O_OD = O_KN;
constexpr size_t O_END = O_KN + (size_t)T * 256 * 2;
constexpr size_t O_BAR = O_END;
constexpr size_t O_END2 = O_BAR + 16384;
constexpr size_t O_G = O_Z;
static_assert(O_G + (size_t)T * 4096 * 2 <= O_ST, "gate buffer overlaps live data");
constexpr size_t O_MG = O_H;
constexpr size_t O_ACT = O_Z;

constexpr int SMEM_BYTES = 73728 + 1024;

struct Params {
  const float* in[23];
  float* out;
  char* ws;
};

DI int tidx() { int t = threadIdx.x & 255; asm volatile("" : "+v"(t)); return t; }
DI int bidx() { int t = __builtin_amdgcn_readfirstlane((int)(blockIdx.x * 2 + (threadIdx.x >> 8))); asm volatile("" : "+s"(t)); return t; }
#define VGRID ((int)gridDim.x * 2)
DI char* lws(char* w) { unsigned long long x = (unsigned long long)w; asm volatile("" : "+s"(x)); return (char*)x; }
DI int rtid() { int t = threadIdx.x; asm volatile("" : "+v"(t)); return t; }
DI int rbid() { int t = blockIdx.x; asm volatile("" : "+s"(t)); return t; }
DI float bf2f(u16 v) { return __uint_as_float(((unsigned)v) << 16); }
DI float bflo(unsigned v) { return __uint_as_float(v << 16); }
DI float bfhi(unsigned v) { return __uint_as_float(v & 0xffff0000u); }
DI unsigned pack2(float a, float b) {
  f2_t v = {a, b};
  return __builtin_bit_cast(unsigned, __builtin_convertvector(v, bf2_t));
}
DI u16 f2bf(float a) { return (u16)(pack2(a, 0.f) & 0xffffu); }
DI float sigmoid_fast(float x) { return __builtin_amdgcn_rcpf(1.f + __expf(-x)); }
DI int crow(int r, int hh) { return (r & 3) + 8 * (r >> 2) + 4 * hh; }
DI void unpack8(const uint4& v, float* x) {
  x[0] = bflo(v.x); x[1] = bfhi(v.x); x[2] = bflo(v.y); x[3] = bfhi(v.y);
  x[4] = bflo(v.z); x[5] = bfhi(v.z); x[6] = bflo(v.w); x[7] = bfhi(v.w);
}
DI uint4 pack8(const float* x) {
  uint4 o; o.x = pack2(x[0], x[1]); o.y = pack2(x[2], x[3]); o.z = pack2(x[4], x[5]); o.w = pack2(x[6], x[7]);
  return o;
}

template <int WN, int PF = 2>
DI void gemm_ml(const u16* __restrict__ A, long lda, const u16* __restrict__ B, long ldb, int K,
                f32x16 (&acc)[2][WN], u16* sm) {
  const int tid = tidx(), lane = tid & 63, wave = tid >> 6, l31 = lane & 31, hh = lane >> 5;
  const int wm = wave >> 1, wn = wave & 1;
  const int chunk = tid & 7, row0 = tid >> 3;
  u16* sa = sm;
  u16* sb = sm + 2 * 128 * 72;
  struct Stg { u32x4 a0, a1, a2, a3, b0, b1, b2, b3; };
  Stg r0, r1;
  const u16* ga = A + (long)row0 * lda + chunk * 8;
  const u16* gb = B + (long)row0 * ldb + chunk * 8;
  const int nk = K >> 6;
#define GLOAD(R, kt_)                                            \
  {                                                              \
    const int ko = (kt_) * 64;                                   \
    R.a0 = *(const u32x4*)(ga + ko);                             \
    R.a1 = *(const u32x4*)(ga + 32 * lda + ko);                  \
    R.a2 = *(const u32x4*)(ga + 64 * lda + ko);                  \
    R.a3 = *(const u32x4*)(ga + 96 * lda + ko);                  \
    R.b0 = *(const u32x4*)(gb + ko);                             \
    R.b1 = *(const u32x4*)(gb + 32 * ldb + ko);                  \
    if (WN == 2) {                                               \
      R.b2 = *(const u32x4*)(gb + 64 * ldb + ko);                \
      R.b3 = *(const u32x4*)(gb + 96 * ldb + ko);                \
    }                                                            \
  }
#define SWRITE(R, buf_)                                                   \
  {                                                                       \
    u16* wa = sa + (buf_) * 128 * 72 + row0 * 72 + chunk * 8;             \
    u16* wb = sb + (buf_) * 128 * 72 + row0 * 72 + chunk * 8;             \
    *(u32x4*)(wa) = R.a0;                                                 \
    *(u32x4*)(wa + 32 * 72) = R.a1;                                       \
    *(u32x4*)(wa + 64 * 72) = R.a2;                                       \
    *(u32x4*)(wa + 96 * 72) = R.a3;                                       \
    *(u32x4*)(wb) = R.b0;                                                 \
    *(u32x4*)(wb + 32 * 72) = R.b1;                                       \
    if (WN == 2) {                                                        \
      *(u32x4*)(wb + 64 * 72) = R.b2;                                     \
      *(u32x4*)(wb + 96 * 72) = R.b3;                                     \
    }                                                                     \
  }
  auto compute = [&](int buf) {
    const u16* pa = sa + buf * 128 * 72 + (wm * 64 + l31) * 72 + hh * 8;
    const u16* pb = sb + buf * 128 * 72 + (wn * 32 * WN + l31) * 72 + hh * 8;
#pragma unroll
    for (int ks = 0; ks < 4; ++ks) {
      bf16x8 af[2], bfr[WN];
#pragma unroll
      for (int mt = 0; mt < 2; ++mt) af[mt] = *(const bf16x8*)(pa + mt * 32 * 72 + ks * 16);
#pragma unroll
      for (int nt = 0; nt < WN; ++nt) bfr[nt] = *(const bf16x8*)(pb + nt * 32 * 72 + ks * 16);
#pragma unroll
      for (int mt = 0; mt < 2; ++mt)
#pragma unroll
        for (int nt = 0; nt < WN; ++nt) acc[mt][nt] = MFMA(af[mt], bfr[nt], acc[mt][nt]);
    }
  };
  if (PF == 2) {
    GLOAD(r0, 0);
    if (nk > 1) GLOAD(r1, 1);
    SWRITE(r0, 0);
    __syncthreads();
#pragma unroll 1
    for (int kt = 0; kt < nk; kt += 2) {
      if (kt + 2 < nk) GLOAD(r0, kt + 2);
      compute(0);
      if (kt + 1 < nk) SWRITE(r1, 1);
      __syncthreads();
      if (kt + 1 >= nk) break;
      if (kt + 3 < nk) GLOAD(r1, kt + 3);
      compute(1);
      if (kt + 2 < nk) SWRITE(r0, 0);
      __syncthreads();
    }
  } else {
    GLOAD(r0, 0);
    SWRITE(r0, 0);
    __syncthreads();
#pragma unroll 1
    for (int kt = 0; kt < nk; ++kt) {
      const int buf = kt & 1;
      if (kt + 1 < nk) GLOAD(r0, kt + 1);
      compute(buf);
      if (kt + 1 < nk) SWRITE(r0, buf ^ 1);
      __syncthreads();
    }
  }
#undef GLOAD
#undef SWRITE
}

template <int WN>
DI void zero_acc(f32x16 (&acc)[2][WN]) {
#pragma unroll
  for (int mt = 0; mt < 2; ++mt)
#pragma unroll
    for (int nt = 0; nt < WN; ++nt)
#pragma unroll
      for (int r = 0; r < 16; ++r) acc[mt][nt][r] = 0.f;
}

template <int WN, class F>
DI void epi(f32x16 (&acc)[2][WN], F f) {
  const int lane = tidx() & 63, wave = tidx() >> 6, l31 = lane & 31, hh = lane >> 5;
  const int wm = wave >> 1, wn = wave & 1;
#pragma unroll
  for (int mt = 0; mt < 2; ++mt)
#pragma unroll
    for (int nt = 0; nt < WN; ++nt)
#pragma unroll
      for (int r = 0; r < 16; ++r)
        f(wm * 64 + mt * 32 + crow(r, hh), wn * 32 * WN + nt * 32 + l31, acc[mt][nt][r]);
}

DI void block_rstd(const u16* base, long ld, int ncols, float* out) {
  const int tid = tidx(), row = tid >> 1, half = tid & 1;
  const int n2 = ncols >> 1;
  const u16* p = base + (long)row * ld + half * n2;
  float ss = 0.f;
  for (int i = 0; i < n2; i += 8) {
    uint4 v = *(const uint4*)(p + i);
    float x[8]; unpack8(v, x);
#pragma unroll
    for (int j = 0; j < 8; ++j) ss += x[j] * x[j];
  }
  ss += __shfl_xor(ss, 1);
  if (half == 0) out[row] = rsqrtf(ss / (float)ncols + EPS);
}

template <class CM, class SC>
DI void convT(u16* dst, int N, int K, const float* __restrict__ src, long ld, CM cm, SC sc, long& rot) {
  const unsigned kblocks = (unsigned)K / 64u;
  const unsigned items = ((unsigned)N / 64u) * kblocks * 64u;
  const unsigned gth = (unsigned)VGRID * 256u;
  const unsigned gtid = (unsigned)bidx() * 256u + (unsigned)tidx();
  const unsigned r = (unsigned)rot;
  const unsigned i0 = gtid >= r ? gtid - r : gtid + gth - r;
  rot = (long)((r + items) % gth);
  for (unsigned i = i0; i < items; i += gth) {
    const int kq = (int)(i & 7u), nl = (int)((i >> 3) & 7u);
    const unsigned rest = i >> 6;
    const int kb = (int)(rest % kblocks), nb = (int)(rest / kblocks);
    const int n = nb * 64 + nl * 8, k0 = kb * 64 + kq * 8;
    const int c = cm(n);
    float4 xa[8], xb[8];
#pragma unroll
    for (int j = 0; j < 8; ++j) {
      xa[j] = make_float4(0.f, 0.f, 0.f, 0.f);
      xb[j] = xa[j];
      if (c >= 0) {
        const f32x4_t ta = __builtin_nontemporal_load((const f32x4_t*)(src + (long)(k0 + j) * ld + c));
        const f32x4_t tb = __builtin_nontemporal_load((const f32x4_t*)(src + (long)(k0 + j) * ld + c + 4));
        xa[j] = make_float4(ta[0], ta[1], ta[2], ta[3]);
        xb[j] = make_float4(tb[0], tb[1], tb[2], tb[3]);
      }
    }
    float v[8][8];
#pragma unroll
    for (int j = 0; j < 8; ++j) {
      const float w = sc(k0 + j);
      v[0][j] = xa[j].x * w; v[1][j] = xa[j].y * w; v[2][j] = xa[j].z * w; v[3][j] = xa[j].w * w;
      v[4][j] = xb[j].x * w; v[5][j] = xb[j].y * w; v[6][j] = xb[j].z * w; v[7][j] = xb[j].w * w;
    }
#pragma unroll
    for (int q = 0; q < 8; ++q) *(uint4*)(dst + (long)(n + q) * K + k0) = pack8(v[q]);
  }
}

DI void ph_wprep(const Params& p, int l) {
  char* ws = lws(p.ws);
  auto one = [](int) { return 1.f; };
  long rot = 0;
  const float* w_in = p.in[2] + (size_t)l * 1024 * INW;
  convT((u16*)(ws + O_WZ), 2560, 1024, w_in, INW,
        [](int n) { return n < 544 ? n : (n < 1056 ? n + 256 : (n < ZW ? n + 512 : -1)); }, one, rot);
  convT((u16*)(ws + O_WF), 512, 1024, w_in, INW, [](int n) { return n < 256 ? 544 + n : 1312 + (n - 256); }, one, rot);
  convT((u16*)(ws + O_WG), 4096, 1024, w_in, INW, [](int n) { return 2848 + n; }, one, rot);
  {
    const float* g = p.in[3] + l * 384;
    convT((u16*)(ws + O_WUQ), 384, 384, p.in[4] + (size_t)l * 384 * 384, 384, [](int n) { return n; },
          [g](int k) { return g[k]; }, rot);
  }
  {
    const float* g = p.in[5] + l * 128;
    const float* w = p.in[6] + (size_t)l * 128 * 512;
    convT((u16*)(ws + O_WKN), 256, 128, w, 512, [](int n) { return (n >> 6) * 128 + (n & 63); }, [g](int k) { return g[k]; }, rot);
    convT((u16*)(ws + O_WV), 256, 128, w, 512, [](int n) { return (n >> 6) * 128 + 64 + (n & 63); }, [g](int k) { return g[k]; }, rot);
  }
  const float* wb = p.in[18] + (size_t)l * 4 * 256 * 1024;
  convT((u16*)(ws + O_WB0), 1024, 256, wb, 1024, [](int n) { return n; }, one, rot);
  convT((u16*)(ws + O_WB2), 1024, 256, wb + 2 * 256 * 1024, 1024, [](int n) { return n; }, one, rot);
  convT((u16*)(ws + O_WB3), 1024, 256, wb + 3 * 256 * 1024, 1024, [](int n) { return n; }, one, rot);
  convT((u16*)(ws + O_WO), 1024, 1024, p.in[19] + (size_t)l * 1024 * 1024, 1024, [](int n) { return n; }, one, rot);
  convT((u16*)(ws + O_WGU), 5632, 1024, p.in[21] + (size_t)l * 1024 * 5632, 5632,
        [](int R) {
          const int tile = R >> 8, w = R & 255;
          const int col = tile * 128 + (w & 127);
          return (w >> 7) ? DFF + col : col;
        },
        one, rot);
  convT((u16*)(ws + O_WD), 1024, 2816, p.in[22] + (size_t)l * DFF * 1024, 1024, [](int n) { return n; }, one, rot);
  {
    u16* dst = (u16*)(ws + O_WB1);
    const float* w1 = wb + 1 * 256 * 1024;
    for (int i = bidx() * 256 + tidx(); i < 1024 * 512; i += VGRID * 256) {
      const int j = i & 1023, kk = i >> 10;
      const int sel = kk >> 8, g = (kk >> 6) & 3, cc = kk & 63;
      float a = 0.f;
#pragma unroll 16
      for (int c2 = 0; c2 < 64; ++c2) {
        const float fr = (float)((cc * c2) & 63) * (1.f / 64.f);
        const float tr = sel ? -__builtin_amdgcn_sinf(fr) : __builtin_amdgcn_cosf(fr);
        a += tr * w1[(g * 64 + c2) * 1024 + j];
      }
      dst[j * 512 + kk] = f2bf(a * 0.125f);
    }
  }
  if (l == 0) {
    float* rc = (float*)(ws + O_RC);
    float* rs = (float*)(ws + O_RS);
    for (int i = bidx() * 256 + tidx(); i < 8192 * 16; i += VGRID * 256) {
      const int pos = i >> 4, fi = i & 15;
      const float invf = 1.0f / exp2f((float)fi * 0.8304820237218407f);
      const float ang = (float)pos * invf;
      double rv = (double)ang * 0.15915494309189535;
      rv -= floor(rv);
      const float fr = (float)rv;
      rc[i] = __builtin_amdgcn_cosf(fr);
      rs[i] = __builtin_amdgcn_sinf(fr);
    }
    u16* e1 = (u16*)(ws + O_E1);
    for (int i = bidx() * 256 + tidx(); i < 256 * 128; i += VGRID * 256) {
      const int R = i >> 7, s1 = i & 127;
      const int p1 = (R >> 7) * 64 + ((R >> 6) & 1) * 32 + (R & 31), ri = (R >> 5) & 1;
      const float fr = (float)((p1 * s1) & 127) * (1.f / 128.f);
      const float v = ri ? -__builtin_amdgcn_sinf(fr) : __builtin_amdgcn_cosf(fr);
      e1[i] = f2bf(v * 0.08838834764831845f);
    }
    u16* e2 = (u16*)(ws + O_E2);
    for (int i = bidx() * 256 + tidx(); i < 128 * 128; i += VGRID * 256) {
      const int R = i >> 7, kk = i & 127;
      const int sel = R >> 6, p2 = R & 63, s2 = kk >> 1, ri = kk & 1;
      const float fr = (float)((p2 * s2) & 63) * (1.f / 64.f);
      const float c = __builtin_amdgcn_cosf(fr), s = __builtin_amdgcn_sinf(fr);
      const float v = sel == 0 ? (ri == 0 ? c : s) : (ri == 0 ? s : -c);
      e2[i] = f2bf(v * 0.125f);
    }
  }
}

DI void ph_rmsnorm(const float* __restrict__ x, const float* __restrict__ g, u16* __restrict__ H) {
  const int lane = tidx() & 63, wave = tidx() >> 6;
  const int nw = VGRID * 4;
#pragma unroll 1
  for (int row0 = (bidx() * 4 + wave) * 4; row0 < T; row0 += nw * 4) {
    float4 v[4][4];
#pragma unroll
    for (int q = 0; q < 4; ++q) {
      const float4* xr = (const float4*)(x + (size_t)(row0 + q) * 1024);
#pragma unroll
      for (int i = 0; i < 4; ++i) {
        const f32x4_t t4 = __builtin_nontemporal_load((const f32x4_t*)(xr + lane + 64 * i));
        v[q][i] = make_float4(t4[0], t4[1], t4[2], t4[3]);
      }
    }
    float4 gg[4];
#pragma unroll
    for (int i = 0; i < 4; ++i) gg[i] = ((const float4*)g)[lane + 64 * i];
#pragma unroll
    for (int q = 0; q < 4; ++q) {
      float ss = 0.f;
#pragma unroll
      for (int i = 0; i < 4; ++i) ss += v[q][i].x * v[q][i].x + v[q][i].y * v[q][i].y + v[q][i].z * v[q][i].z + v[q][i].w * v[q][i].w;
#pragma unroll
      for (int o = 32; o >= 1; o >>= 1) ss += __shfl_xor(ss, o);
      const float r = rsqrtf(ss * (1.f / 1024.f) + EPS);
#pragma unroll
      for (int i = 0; i < 4; ++i) {
        uint2 o;
        o.x = pack2(v[q][i].x * r * gg[i].x, v[q][i].y * r * gg[i].y);
        o.y = pack2(v[q][i].z * r * gg[i].z, v[q][i].w * r * gg[i].w);
        *(uint2*)(H + (size_t)(row0 + q) * 1024 + (lane + 64 * i) * 4) = o;
      }
    }
  }
}


namespace pg8 {
#define PG8_LAS __attribute__((address_space(3)))
typedef unsigned short bf16_t;
typedef short bf16x8 __attribute__((ext_vector_type(8)));
typedef float f32x4 __attribute__((ext_vector_type(4)));
typedef unsigned u32x4 __attribute__((ext_vector_type(4)));
constexpr int BM = 256, BK = 64, HALF = 128, HTB = HALF * BK * 2  , STAGE_BYTES = 8 * HTB, NXCD = 8, WGM = 8;

__host__ __device__ __forceinline__ int lds_byte(int r, int c) { const int st = (r >> 4) * 2 + (c >> 5), rr = r & 15, cc = c & 31, ob = rr * 64 + cc * 2; return st * 1024 + (ob ^ (((ob >> 9) & 1) << 5)); }
__host__ __device__ __forceinline__ void stage_rc(int b, int& R, int& C) { const int st = b / 1024, sb = b % 1024, swz = sb ^ (((sb >> 9) & 1) << 5); R = (st >> 1) * 16 + swz / 64; C = (st & 1) * 32 + (swz % 64) / 2; }
__host__ __device__ __forceinline__ int perm32(int rho) { const int n = rho >> 4, i = rho & 15; return 8 * (i >> 2) + 4 * n + (i & 3); }

struct Unit { int pm, pn; };
struct Gemm { const bf16_t* A; const bf16_t* Bt; int M, N, K; };

struct StaticOrder {
    static constexpr bool CUSTOM_B = false;
    __device__ __forceinline__ int ldb_() const { return 0; }
    __device__ __forceinline__ size_t hstepB_() const { return 0; }
    __device__ __forceinline__ const char* bbase_(const Gemm&, const Unit&) const { return nullptr; }
    int nM, nN, nwg, G, c;
    __host__ __device__ void init(int M, int N, int G_, int c_) { nM = M / BM; nN = N / BM; nwg = nM * nN; G = G_; c = c_; }
    __host__ __device__ bool next(int i, Unit& u) const {
        const long L = (long)i * G + c; if (L >= nwg) return false;
        int wgid = (int)L; { const int q = nwg / NXCD, r = nwg % NXCD, xcd = wgid % NXCD, off = wgid / NXCD; wgid = (xcd < r ? xcd * (q + 1) : r * (q + 1) + (xcd - r) * q) + off; }
        const int nig = WGM * nN, gid = wgid / nig, fm = gid * WGM, gsz = (nM - fm) < WGM ? (nM - fm) : WGM;
        u.pm = fm + ((wgid % nig) % gsz); u.pn = (wgid % nig) / gsz; return true;
    }
    __device__ __forceinline__ void a_ready(const Unit&) const {}
    __device__ __forceinline__ void done(const Unit&) const {}
};
template <class Epi, class Sched, bool STAMP = false>
__device__ __forceinline__ void gemm_phase(PG8_LAS unsigned char* lds, const Gemm g, const Sched& S, const Epi& E, unsigned long long* stamps) {
    int tid_ = threadIdx.x; asm volatile("" : "+v"(tid_));
    const int tid = tid_, wid = __builtin_amdgcn_readfirstlane(tid >> 6), lane = tid & 63, wr = wid >> 2, wc = wid & 3, fr = lane & 15, fq = lane >> 4;
    const int K = g.K, nt = K / BK;
    int ts_lo = 0, ts_hi = 0, nts = 0; const unsigned long long rt_entry = STAMP ? (unsigned long long)wall_clock64() : 0ull;
#define PG8_STAMP() do { if (STAMP && wid == 0 && nts < 64) { const unsigned long long _c = (unsigned long long)clock64(); \
        ts_lo = (lane == nts) ? (int)(unsigned)_c : ts_lo; ts_hi = (lane == nts) ? (int)(unsigned)(_c >> 32) : ts_hi; ++nts; } } while (0)
    PG8_STAMP();
    unsigned voffA[2], voffB[2];
#pragma unroll
    for (int i = 0; i < 2; ++i) { int R, C; stage_rc(tid * 16 + i * 8192, R, C); const int Rb = Epi::PERM ? ((R & ~31) + perm32(R & 31)) : R;
        voffA[i] = (unsigned)(R * K + C) * 2u; voffB[i] = (unsigned)(Rb * (Sched::CUSTOM_B ? S.ldb_() : K) + C) * 2u; }
    const size_t kstep = (size_t)(BK * 2);
    const size_t hstep = (size_t)HALF * K * 2;
    const size_t tstep = 2 * hstep;
    const size_t hstepB = Sched::CUSTOM_B ? S.hstepB_() : hstep;
    const unsigned ldsw = (unsigned)wid * 1024u;
    const int aoff = lds_byte(wr * 64 + fr, fq * 8), boff = lds_byte(wc * 32 + fr, fq * 8);
#define PG8_SA(b, h) (((b) * 2 + (h)) * HTB)
#define PG8_SB(b, h) ((4 + (b) * 2 + (h)) * HTB)
#define PG8_STAGE(bufoff, gbase, voff) do { _Pragma("unroll") for (int _i = 0; _i < 2; ++_i) \
        __builtin_amdgcn_global_load_lds((const unsigned*)((const char*)(gbase) + (voff)[_i]), (PG8_LAS unsigned*)(lds + (bufoff) + ldsw + _i * 8192), 16, 0, 0); } while (0)
#define PG8_LDA(dst, b, h) do { _Pragma("unroll") for (int m = 0; m < 4; ++m) _Pragma("unroll") for (int k = 0; k < 2; ++k) dst[m][k] = *(const PG8_LAS bf16x8*)(lds + PG8_SA(b, h) + aoff + m * 2048 + k * 1024); } while (0)
#define PG8_LDB(dst, b, h) do { _Pragma("unroll") for (int n = 0; n < 2; ++n) _Pragma("unroll") for (int k = 0; k < 2; ++k) dst[n][k] = *(const PG8_LAS bf16x8*)(lds + PG8_SB(b, h) + boff + n * 2048 + k * 1024); } while (0)
#define PG8_MMA(ai, bj, At, Bt) do { __builtin_amdgcn_s_setprio(1); _Pragma("unroll") for (int m = 0; m < 4; ++m) _Pragma("unroll") for (int n = 0; n < 2; ++n) _Pragma("unroll") for (int k = 0; k < 2; ++k) \
        acc[ai][bj][m][n] = __builtin_amdgcn_mfma_f32_16x16x32_bf16(Bt[n][k], At[m][k], acc[ai][bj][m][n], 0, 0, 0); __builtin_amdgcn_s_setprio(0); } while (0)
#define PG8_WAIT_V(n) asm volatile("s_waitcnt vmcnt(" #n ")" ::: "memory")
#define PG8_WAIT_L(n) asm volatile("s_waitcnt lgkmcnt(" #n ")" ::: "memory")
#define PG8_BAR __builtin_amdgcn_s_barrier()
#define PG8_SCHED __builtin_amdgcn_sched_barrier(0)
    Unit cur, nxt; int ui = 0;
    if (!S.next(0, cur)) return;
    f32x4 acc[2][2][4][2];
#pragma unroll
    for (int a = 0; a < 2; ++a)
#pragma unroll
        for (int b = 0; b < 2; ++b)
#pragma unroll
            for (int m = 0; m < 4; ++m)
#pragma unroll
                for (int n = 0; n < 2; ++n) acc[a][b][m][n] = (f32x4){0.f, 0.f, 0.f, 0.f};
    bf16x8 At[4][2], B0[2][2], B1[2][2];
    const char* cA = (const char*)g.A + (size_t)cur.pm * tstep; const char* cB = Sched::CUSTOM_B ? S.bbase_(g, cur) : (const char*)g.Bt + (size_t)cur.pn * tstep;
    S.a_ready(cur);
    PG8_STAGE(PG8_SB(0, 0), cB, voffB); PG8_STAGE(PG8_SA(0, 0), cA, voffA); PG8_STAGE(PG8_SB(0, 1), cB + hstepB, voffB); PG8_STAGE(PG8_SA(0, 1), cA + hstep, voffA);
    if (wr == 1) PG8_BAR;
    PG8_WAIT_V(4); PG8_BAR;
    PG8_STAGE(PG8_SB(1, 0), cB + kstep, voffB); PG8_STAGE(PG8_SA(1, 0), cA + kstep, voffA); PG8_STAGE(PG8_SB(1, 1), cB + hstepB + kstep, voffB);
    PG8_WAIT_V(6); PG8_BAR;
    PG8_STAMP();
    for (;;) {
        const bool has_next = S.next(ui + 1, nxt);
        const char* nA = has_next ? (const char*)g.A + (size_t)nxt.pm * tstep : cA; const char* nB = has_next ? (Sched::CUSTOM_B ? S.bbase_(g, nxt) : (const char*)g.Bt + (size_t)nxt.pn * tstep) : cB;
        for (int t = 0; t < nt; t += 2) {
            const bool last = (t == nt - 2);
            const char* a1 = cA + (size_t)(t + 1) * kstep;
            const char* a2 = last ? nA : cA + (size_t)(t + 2) * kstep; const char* b2 = last ? nB : cB + (size_t)(t + 2) * kstep;
            const char* a3 = a2 + kstep; const char* b3 = b2 + kstep;
            if (last && has_next) S.a_ready(nxt);
            PG8_LDB(B0, 0, 0); PG8_SCHED; PG8_LDA(At, 0, 0); PG8_STAGE(PG8_SA(1, 1), a1 + hstep, voffA);
            PG8_WAIT_L(8); PG8_BAR; PG8_WAIT_L(0); PG8_MMA(0, 0, At, B0); PG8_BAR; PG8_SCHED;
            PG8_LDB(B1, 0, 1); PG8_STAGE(PG8_SB(0, 0), b2, voffB);
            PG8_BAR; PG8_WAIT_L(0); PG8_MMA(0, 1, At, B1); PG8_BAR;
            PG8_LDA(At, 0, 1); PG8_STAGE(PG8_SA(0, 0), a2, voffA);
            PG8_BAR; PG8_WAIT_L(0); PG8_MMA(1, 0, At, B0); PG8_BAR; PG8_SCHED;
            PG8_STAGE(PG8_SB(0, 1), b2 + hstepB, voffB);
            PG8_WAIT_V(6); PG8_BAR; PG8_MMA(1, 1, At, B1); PG8_BAR;
            PG8_LDB(B0, 1, 0); PG8_SCHED; PG8_LDA(At, 1, 0); PG8_STAGE(PG8_SA(0, 1), a2 + hstep, voffA);
            PG8_WAIT_L(8); PG8_BAR; PG8_WAIT_L(0); PG8_MMA(0, 0, At, B0); PG8_BAR; PG8_SCHED;
            PG8_LDB(B1, 1, 1); PG8_STAGE(PG8_SB(1, 0), b3, voffB);
            PG8_BAR; PG8_WAIT_L(0); PG8_MMA(0, 1, At, B1); PG8_BAR;
            PG8_LDA(At, 1, 1); PG8_STAGE(PG8_SA(1, 0), a3, voffA);
            PG8_BAR; PG8_WAIT_L(0); PG8_MMA(1, 0, At, B0); PG8_BAR; PG8_SCHED;
            PG8_STAGE(PG8_SB(1, 1), b3 + hstepB, voffB);
            PG8_WAIT_V(6); PG8_BAR; PG8_MMA(1, 1, At, B1); PG8_BAR;
        }
        PG8_STAMP();
        if constexpr (!Epi::AFTER_DRAIN) { E(acc, cur, wr, wc, fr, fq); S.done(cur); }
        PG8_STAMP();
        if (!has_next) break;
#pragma unroll
        for (int a = 0; a < 2; ++a)
#pragma unroll
            for (int b = 0; b < 2; ++b)
#pragma unroll
                for (int m = 0; m < 4; ++m)
#pragma unroll
                    for (int n = 0; n < 2; ++n) acc[a][b][m][n] = (f32x4){0.f, 0.f, 0.f, 0.f};
        cur = nxt; cA = nA; cB = nB; ++ui;
    }
    PG8_WAIT_V(0);
    if (wr == 0) PG8_BAR;
    PG8_BAR;
    if constexpr (Epi::AFTER_DRAIN) { E.fused(acc, cur, wr, wc, fr, fq, lds, wid, lane); S.done(cur); }
    PG8_STAMP();
    if (STAMP && wid == 0) { stamps[lane] = lane < nts ? (((unsigned long long)(unsigned)ts_hi << 32) | (unsigned)ts_lo) : 0ull;
        if (lane == 62) stamps[62] = rt_entry; if (lane == 63) stamps[63] = (unsigned long long)wall_clock64(); }
#undef PG8_STAMP
#undef PG8_SA
#undef PG8_SB
#undef PG8_STAGE
#undef PG8_LDA
#undef PG8_LDB
#undef PG8_MMA
#undef PG8_WAIT_V
#undef PG8_WAIT_L
#undef PG8_BAR
#undef PG8_SCHED
}
}

struct EpiZ {
  static constexpr bool PERM = true, AFTER_DRAIN = false;
  u16* Z;
  DI void operator()(const pg8::f32x4 (&acc)[2][2][4][2], const pg8::Unit& u, int wr, int wc, int fr, int fq) const {
    const int row0 = u.pm * 256 + wr * 64 + fr, col0 = u.pn * 256 + wc * 32 + 8 * fq;
#pragma unroll
    for (int ai = 0; ai < 2; ++ai)
#pragma unroll
      for (int m = 0; m < 4; ++m) {
        u16* rowp = Z + (size_t)(row0 + ai * 128 + m * 16) * ZW;
#pragma unroll
        for (int bj = 0; bj < 2; ++bj) {
          const int col = col0 + bj * 128;
          if (col < ZW) {
            const pg8::f32x4 v0 = acc[ai][bj][m][0], v1 = acc[ai][bj][m][1];
            u32x4 w;
            w[0] = pack2(v0[0], v0[1]); w[1] = pack2(v0[2], v0[3]); w[2] = pack2(v1[0], v1[1]); w[3] = pack2(v1[2], v1[3]);
            *(u32x4*)(rowp + col) = w;
          }
        }
      }
  }
};
struct EpiRes {
  static constexpr bool PERM = false, AFTER_DRAIN = false;
  const float* xin;
  float* xout;
  DI void operator()(const pg8::f32x4 (&acc)[2][2][4][2], const pg8::Unit& u, int wr, int wc, int fr, int fq) const {
    const int row0 = u.pm * 256 + wr * 64 + fr, col0 = u.pn * 256 + wc * 32 + 4 * fq;
    pg8::f32x4 xc[2][2], xn[2][2];
#pragma unroll
    for (int bj = 0; bj < 2; ++bj)
#pragma unroll
      for (int n = 0; n < 2; ++n) xn[bj][n] = *(const pg8::f32x4*)(xin + (size_t)row0 * 1024 + col0 + bj * 128 + n * 16);
#pragma unroll
    for (int g = 0; g < 8; ++g) {
      const int ai = g >> 2, m = g & 3;
      const size_t off = (size_t)(row0 + ai * 128 + m * 16) * 1024 + col0;
#pragma unroll
      for (int bj = 0; bj < 2; ++bj)
#pragma unroll
        for (int n = 0; n < 2; ++n) xc[bj][n] = xn[bj][n];
      if (g + 1 < 8) {
        const int ai2 = (g + 1) >> 2, m2 = (g + 1) & 3;
        const size_t off2 = (size_t)(row0 + ai2 * 128 + m2 * 16) * 1024 + col0;
#pragma unroll
        for (int bj = 0; bj < 2; ++bj)
#pragma unroll
          for (int n = 0; n < 2; ++n) xn[bj][n] = *(const pg8::f32x4*)(xin + off2 + bj * 128 + n * 16);
      }
#pragma unroll
      for (int bj = 0; bj < 2; ++bj)
#pragma unroll
        for (int n = 0; n < 2; ++n) *(pg8::f32x4*)(xout + off + bj * 128 + n * 16) = xc[bj][n] + acc[ai][bj][m][n];
    }
  }
};
struct EpiSwi {
  static constexpr bool PERM = true, AFTER_DRAIN = false;
  u16* ACT;
  DI void operator()(const pg8::f32x4 (&acc)[2][2][4][2], const pg8::Unit& u, int wr, int wc, int fr, int fq) const {
    const int row0 = u.pm * 256 + wr * 64 + fr, col0 = u.pn * 128 + wc * 32 + 8 * fq;
#pragma unroll
    for (int ai = 0; ai < 2; ++ai)
#pragma unroll
      for (int m = 0; m < 4; ++m) {
        float a[8];
#pragma unroll
        for (int n = 0; n < 2; ++n)
#pragma unroll
          for (int j = 0; j < 4; ++j) {
            const float g = acc[ai][0][m][n][j], up = acc[ai][1][m][n][j];
            a[n * 4 + j] = g * sigmoid_fast(g) * up;
          }
        u32x4 w;
        w[0] = pack2(a[0], a[1]); w[1] = pack2(a[2], a[3]); w[2] = pack2(a[4], a[5]); w[3] = pack2(a[6], a[7]);
        *(u32x4*)(ACT + (size_t)(row0 + ai * 128 + m * 16) * DFF + col0) = w;
      }
  }
};

struct EpiSig {
  static constexpr bool PERM = true, AFTER_DRAIN = false;
  u16* G;
  DI void operator()(const pg8::f32x4 (&acc)[2][2][4][2], const pg8::Unit& u, int wr, int wc, int fr, int fq) const {
    const int row0 = u.pm * 256 + wr * 64 + fr, col0 = u.pn * 256 + wc * 32 + 8 * fq;
#pragma unroll
    for (int ai = 0; ai < 2; ++ai)
#pragma unroll
      for (int m = 0; m < 4; ++m) {
        u16* rowp = G + (size_t)(row0 + ai * 128 + m * 16) * 4096 + col0;
#pragma unroll
        for (int bj = 0; bj < 2; ++bj) {
          const pg8::f32x4 v0 = acc[ai][bj][m][0], v1 = acc[ai][bj][m][1];
          u32x4 w;
          w[0] = pack2(sigmoid_fast(v0[0]), sigmoid_fast(v0[1])); w[1] = pack2(sigmoid_fast(v0[2]), sigmoid_fast(v0[3]));
          w[2] = pack2(sigmoid_fast(v1[0]), sigmoid_fast(v1[1])); w[3] = pack2(sigmoid_fast(v1[2]), sigmoid_fast(v1[3]));
          *(u32x4*)(rowp + bj * 128) = w;
        }
      }
  }
};

struct EpiMrg {
  static constexpr bool PERM = true, AFTER_DRAIN = false;
  const u16* G;
  u16* MG;
  bool FIRST;
  DI void operator()(const pg8::f32x4 (&acc)[2][2][4][2], const pg8::Unit& u, int wr, int wc, int fr, int fq) const {
    const int row0 = u.pm * 256 + wr * 64 + fr, col0 = u.pn * 256 + wc * 32 + 8 * fq;
    u32x4 gn[2][2];
#pragma unroll
    for (int mm = 0; mm < 2; ++mm)
#pragma unroll
      for (int bj = 0; bj < 2; ++bj) gn[mm][bj] = __builtin_nontemporal_load((const u32x4*)(G + (size_t)(row0 + mm * 16) * 4096 + col0 + bj * 128));
#pragma unroll
    for (int bt = 0; bt < 4; ++bt) {
      const int ai = bt >> 1, mp = bt & 1;
      u32x4 gv[2][2], mv[2][2];
#pragma unroll
      for (int mm = 0; mm < 2; ++mm)
#pragma unroll
        for (int bj = 0; bj < 2; ++bj) {
          const size_t row = (size_t)(row0 + ai * 128 + (2 * mp + mm) * 16);
          gv[mm][bj] = gn[mm][bj];
          mv[mm][bj] = (u32x4){0u, 0u, 0u, 0u};
          if (!FIRST) mv[mm][bj] = *(const u32x4*)(MG + row * 1024 + col0 + bj * 128);
        }
      if (bt + 1 < 4) {
        const int ai2 = (bt + 1) >> 1, mp2 = (bt + 1) & 1;
#pragma unroll
        for (int mm = 0; mm < 2; ++mm)
#pragma unroll
          for (int bj = 0; bj < 2; ++bj)
            gn[mm][bj] = __builtin_nontemporal_load((const u32x4*)(G + (size_t)(row0 + ai2 * 128 + (2 * mp2 + mm) * 16) * 4096 + col0 + bj * 128));
      }
#pragma unroll
      for (int mm = 0; mm < 2; ++mm)
#pragma unroll
        for (int bj = 0; bj < 2; ++bj) {
          const size_t row = (size_t)(row0 + ai * 128 + (2 * mp + mm) * 16);
          const int col = col0 + bj * 128;
          const pg8::f32x4 v0 = acc[ai][bj][2 * mp + mm][0], v1 = acc[ai][bj][2 * mp + mm][1];
          const u32x4 g4 = gv[mm][bj], m4 = mv[mm][bj];
          float o[8];
          o[0] = bflo(m4[0]) + bflo(g4[0]) * v0[0]; o[1] = bfhi(m4[0]) + bfhi(g4[0]) * v0[1];
          o[2] = bflo(m4[1]) + bflo(g4[1]) * v0[2]; o[3] = bfhi(m4[1]) + bfhi(g4[1]) * v0[3];
          o[4] = bflo(m4[2]) + bflo(g4[2]) * v1[0]; o[5] = bfhi(m4[2]) + bfhi(g4[2]) * v1[1];
          o[6] = bflo(m4[3]) + bflo(g4[3]) * v1[2]; o[7] = bfhi(m4[3]) + bfhi(g4[3]) * v1[3];
          u32x4 w;
          w[0] = pack2(o[0], o[1]); w[1] = pack2(o[2], o[3]); w[2] = pack2(o[4], o[5]); w[3] = pack2(o[6], o[7]);
          *(u32x4*)(MG + row * 1024 + col) = w;
        }
      asm volatile("" ::: "memory");
    }
  }
};

struct FeatOrder {
  static constexpr bool CUSTOM_B = true;
  int c;
  DI bool fnet() const { return c < 128; }
  DI int ldb_() const { return fnet() ? 64 * 1024 : 1024; }
  DI size_t hstepB_() const { return fnet() ? (size_t)1024 * 2 : (size_t)128 * 1024 * 2; }
  DI const char* bbase_(const pg8::Gemm& g, const pg8::Unit& u) const {
    if (fnet()) { const int b = u.pn >> 5, q = u.pn & 31; return (const char*)g.Bt + ((size_t)b * 8192 + 2 * q) * 1024 * 2; }
    return (const char*)g.Bt + (size_t)u.pn * 256 * 1024 * 2;
  }
  DI bool next(int i, pg8::Unit& u) const {
    if (i > 0) return false;
    u.pm = fnet() ? 0 : 1;
    u.pn = fnet() ? c : c - 128;
    return true;
  }
  DI void a_ready(const pg8::Unit&) const {}
  DI void done(const pg8::Unit&) const {}
};
struct EpiFeat {
  static constexpr bool PERM = true, AFTER_DRAIN = false;
  u16* UT;
  u16* VDT;
  DI void operator()(const pg8::f32x4 (&acc)[2][2][4][2], const pg8::Unit& u, int wr, int wc, int fr, int fq) const {
    const int feat0 = wr * 64 + fr, j0 = wc * 32 + 8 * fq;
#pragma unroll
    for (int ai = 0; ai < 2; ++ai)
#pragma unroll
      for (int m = 0; m < 4; ++m) {
        const int feat = feat0 + ai * 128 + m * 16;
#pragma unroll
        for (int bj = 0; bj < 2; ++bj) {
          const int j = j0 + bj * 128;
          const pg8::f32x4 v0 = acc[ai][bj][m][0], v1 = acc[ai][bj][m][1];
          u32x4 w;
          w[0] = pack2(v0[0], v0[1]); w[1] = pack2(v0[2], v0[3]); w[2] = pack2(v1[0], v1[1]); w[3] = pack2(v1[2], v1[3]);
          if (u.pm == 0) {
            const int b = u.pn >> 5, s2 = 2 * (u.pn & 31) + (j >> 7), s1 = j & 127;
            *(u32x4*)(UT + (((size_t)b * 256 + feat) * 64 + s2) * 128 + s1) = w;
          } else {
            *(u32x4*)(VDT + (size_t)feat * T + (size_t)u.pn * 256 + j) = w;
          }
        }
      }
  }
};

template <class Epi>
DI void run_gemm8(u16* sm_all, const u16* A, const u16* Bt, int M, int N, int K, const Epi& E) {
  pg8::Gemm g;
  g.A = A; g.Bt = Bt; g.M = M; g.N = N; g.K = K;
  pg8::StaticOrder S;
  S.init(M, N, (int)gridDim.x, (int)blockIdx.x);
  pg8::gemm_phase<Epi, pg8::StaticOrder, false>((PG8_LAS unsigned char*)sm_all, g, S, E, nullptr);
}

DI void ph_inproj(const Params& p, u16* sm) {
  char* ws = lws(p.ws);
  const u16* H = (const u16*)(ws + O_H);
  u16* UT = (u16*)(ws + O_UT);
  u16* VDT = (u16*)(ws + O_VDT);
#pragma unroll 1
  for (int j = bidx(); j < 4 * 256; j += VGRID) {
    f32x16 acc[2][2];
    zero_acc<2>(acc);
    const int tmf = j & 3, nt = j >> 2;
    const u16* A = (const u16*)(ws + O_WF) + (size_t)tmf * 128 * 1024;
    if (tmf < 2) {
      const int b = nt >> 6, s2 = nt & 63;
      gemm_ml<2>(A, 1024, H + ((size_t)b * 8192 + s2) * 1024, 64 * 1024, 1024, acc, sm);
      epi<2>(acc, [&](int m, int n, float v) {
        const int c = tmf * 128 + m;
        UT[(((size_t)b * 256 + c) * 64 + s2) * 128 + n] = f2bf(v);
      });
    } else {
      gemm_ml<2>(A, 1024, H + (size_t)nt * 128 * 1024, 1024, 1024, acc, sm);
      epi<2>(acc, [&](int m, int n, float v) {
        const int feat = (tmf - 2) * 128 + m;
        VDT[(size_t)feat * T + nt * 128 + n] = f2bf(v);
      });
    }
  }
}

DI float hgrn_lb(const Params& p, int l, int dir, int ch) {
  if (l == 0) return 0.f;
  const float* lg = p.in[16] + dir * 2 * 256;
  const float x0 = lg[ch], x1 = lg[256 + ch];
  return 1.f / (1.f + expf(x0 - x1));
}

DI void hgrn_gates(const u16 (&zraw)[16], float lb, int dir, int w, int k, float* tot  ,
                   float (&cum)[16], float (&kk)[16], float& total) {
  float lf[16];
#pragma unroll
  for (int j = 0; j < 16; ++j) {
    const float z = bf2f(zraw[j]);
    const float sg = __builtin_amdgcn_rcpf(1.f + __expf(-z));
    const float f = lb + (1.f - lb) * sg;
    lf[j] = __logf(f);
    kk[j] = 1.f - f;
  }
  float pre[16];
  float run = 0.f;
#pragma unroll
  for (int j = 0; j < 16; ++j) { run += lf[j]; pre[j] = run; }
  tot[w * 64 + k] = run;
  __syncthreads();
  const float t0 = tot[k], t1 = tot[64 + k], t2 = tot[128 + k], t3 = tot[192 + k];
  total = t0 + t1 + t2 + t3;
  float before = 0.f;
  if (w > 0) before += t0;
  if (w > 1) before += t1;
  if (w > 2) before += t2;
  const float after = total - before - run;
#pragma unroll
  for (int j = 0; j < 16; ++j) cum[j] = dir ? (after + run - pre[j] + lf[j]) : (before + pre[j]);
}

DI void hgrn_h1_load(const Params& p, int item, u16 (&zraw)[16], u16 (&vraw)[16]) {
  const u16* Z = (const u16*)(p.ws + O_Z);
  const int chunk = item & 127, dir = (item >> 7) & 1, h = (item >> 8) & 3, b = item >> 10;
  const int tid = tidx(), k = tid & 63, w = tid >> 6;
  const size_t tok0 = (size_t)b * 8192 + chunk * 64;
  const u16* zc = Z + (tok0 + w * 16) * ZW + h * 64 + k;
#pragma unroll
  for (int j = 0; j < 16; ++j) { zraw[j] = zc[(size_t)j * ZW + (dir ? 1824 : 1568)]; vraw[j] = zc[(size_t)j * ZW + 1312]; }
}
DI void hgrn_h1(const Params& p, int l, int item, u16* sm, const u16 (&zraw)[16], const u16 (&vraw)[16]) {
  char* ws = lws(p.ws);
  u16* ST = (u16*)(ws + O_ST);
  float* DEC = (float*)(ws + O_DEC);
  const int chunk = item & 127, dir = (item >> 7) & 1, h = (item >> 8) & 3, b = item >> 10;
  const int tid = tidx(), k = tid & 63, w = tid >> 6, lane = tid & 63, l31 = lane & 31, hh = lane >> 5;
  const size_t tok0 = (size_t)b * 8192 + chunk * 64;
  u16* KT = sm;
  u16* VT = sm + 64 * 72;
  float* tot = (float*)(sm + 2 * 64 * 72);
  float cum[16], kk[16], total;
  hgrn_gates(zraw, hgrn_lb(p, l, dir, h * 64 + k), dir, w, k, tot, cum, kk, total);
  float kv[16], vv[16];
#pragma unroll
  for (int j = 0; j < 16; ++j) {
    kv[j] = kk[j] * __expf(total - cum[j]);
    vv[j] = bf2f(vraw[j]);
  }
  *(uint4*)(KT + k * 72 + w * 16) = pack8(kv);
  *(uint4*)(KT + k * 72 + w * 16 + 8) = pack8(kv + 8);
  *(uint4*)(VT + k * 72 + w * 16) = pack8(vv);
  *(uint4*)(VT + k * 72 + w * 16 + 8) = pack8(vv + 8);
  if (w == 0) DEC[(size_t)item * 64 + k] = expf(total);
  __syncthreads();
  const int mt = w >> 1, nt = w & 1;
  f32x16 acc;
#pragma unroll
  for (int r = 0; r < 16; ++r) acc[r] = 0.f;
#pragma unroll
  for (int ks = 0; ks < 4; ++ks) {
    const bf16x8 a = *(const bf16x8*)(VT + (mt * 32 + l31) * 72 + ks * 16 + hh * 8);
    const bf16x8 bq = *(const bf16x8*)(KT + (nt * 32 + l31) * 72 + ks * 16 + hh * 8);
    acc = MFMA(a, bq, acc);
  }
#pragma unroll
  for (int r = 0; r < 16; ++r) ST[(size_t)item * 4096 + (mt * 32 + crow(r, hh)) * 64 + nt * 32 + l31] = f2bf(acc[r]);
  __syncthreads();
}

DI void hgrn_h2(const Params& p) {
  char* ws = lws(p.ws);
  u16* ST = (u16*)(ws + O_ST);
  const float* DEC = (const float*)(ws + O_DEC);
  for (int pi = bidx() * 256 + tidx(); pi < 32 * 2048; pi += VGRID * 256) {
    const int chain = pi >> 11, e2 = pi & 2047, dir = chain & 1;
    const int k = (2 * e2) & 63;
    float s0 = 0.f, s1 = 0.f;
#pragma unroll 1
    for (int c0 = 0; c0 < 128; c0 += 32) {
      unsigned uv[32];
      float2 dv[32];
#pragma unroll
      for (int j = 0; j < 32; ++j) {
        const int chunk = dir ? 127 - (c0 + j) : (c0 + j);
        const size_t item = (size_t)chain * 128 + chunk;
        uv[j] = *(const unsigned*)(ST + item * 4096 + 2 * e2);
        dv[j] = *(const float2*)(DEC + item * 64 + k);
      }
#pragma unroll
      for (int j = 0; j < 32; ++j) {
        const int chunk = dir ? 127 - (c0 + j) : (c0 + j);
        const size_t item = (size_t)chain * 128 + chunk;
        *(unsigned*)(ST + item * 4096 + 2 * e2) = pack2(s0, s1);
        s0 = dv[j].x * s0 + bflo(uv[j]);
        s1 = dv[j].y * s1 + bfhi(uv[j]);
      }
    }
  }
}

DI void hgrn_h3(const Params& p, int l, int item, u16* sm) {
  char* ws = lws(p.ws);
  const u16* Z = (const u16*)(ws + O_Z);
  const u16* ST = (const u16*)(ws + O_ST);
  u16* OH = (u16*)(ws + O_OH);
  const int chunk = item & 127, h = (item >> 7) & 3, b = item >> 9;
  const int tid = tidx(), k = tid & 63, w = tid >> 6, lane = tid & 63, l31 = lane & 31, hh = lane >> 5;
  const size_t tok0 = (size_t)b * 8192 + chunk * 64;
  u16* Q1 = sm;
  u16* Q2 = sm + 64 * 72;
  u16* KT = sm + 2 * 64 * 72;
  u16* VT = sm + 3 * 64 * 72;
  float* tot = (float*)(sm + 4 * 64 * 72);
  float* ssum = tot + 256;
  const int vt = w >> 1, tt = w & 1;
  u16 zf[16], zb[16], qraw[16];
  {
    const u16* zc = Z + (tok0 + w * 16) * ZW + h * 64 + k;
    u16 vraw[16];
#pragma unroll
    for (int j = 0; j < 16; ++j) {
      vraw[j] = zc[(size_t)j * ZW + 1312];
      zf[j] = zc[(size_t)j * ZW + 1568];
      zb[j] = zc[(size_t)j * ZW + 1824];
      qraw[j] = zc[(size_t)j * ZW + 1056];
    }
    float vv[16];
#pragma unroll
    for (int j = 0; j < 16; ++j) vv[j] = bf2f(vraw[j]);
    *(uint4*)(VT + k * 72 + w * 16) = pack8(vv);
    *(uint4*)(VT + k * 72 + w * 16 + 8) = pack8(vv + 8);
  }
  bf16x8 stf[2][4];
#pragma unroll
  for (int d2 = 0; d2 < 2; ++d2) {
    const size_t sti = ((size_t)((b * 4 + h) * 2 + d2) * 128 + chunk) * 4096;
#pragma unroll
    for (int ks = 0; ks < 4; ++ks) stf[d2][ks] = *(const bf16x8*)(ST + sti + (vt * 32 + l31) * 64 + ks * 16 + hh * 8);
  }
  f32x16 O;
#pragma unroll
  for (int r = 0; r < 16; ++r) O[r] = 0.f;
#pragma unroll
  for (int dir = 0; dir < 2; ++dir) {
    float cum[16], kk[16], total;
    if (dir) hgrn_gates(zb, hgrn_lb(p, l, 1, h * 64 + k), 1, w, k, tot, cum, kk, total);
    else hgrn_gates(zf, hgrn_lb(p, l, 0, h * 64 + k), 0, w, k, tot, cum, kk, total);
    const float ref = 0.5f * total;
#pragma unroll
    for (int j = 0; j < 16; ++j) {
      const int t = w * 16 + j;
      const float q = bf2f(qraw[j]);
      Q1[t * 72 + k] = f2bf(q * __expf(cum[j] - ref));
      Q2[t * 72 + k] = f2bf(q * __expf(cum[j]));
      KT[t * 72 + k] = f2bf(kk[j] * __expf(ref - cum[j]));
    }
    __syncthreads();
#pragma unroll
    for (int sb = 0; sb < 2; ++sb) {
      f32x16 sc;
#pragma unroll
      for (int r = 0; r < 16; ++r) sc[r] = 0.f;
#pragma unroll
      for (int ks = 0; ks < 4; ++ks) {
        const bf16x8 a = *(const bf16x8*)(KT + (sb * 32 + l31) * 72 + ks * 16 + hh * 8);
        const bf16x8 bq = *(const bf16x8*)(Q1 + (tt * 32 + l31) * 72 + ks * 16 + hh * 8);
        sc = MFMA(a, bq, sc);
      }
      const int tcol = tt * 32 + l31;
      float pm[16];
#pragma unroll
      for (int r = 0; r < 16; ++r) {
        const int srow = sb * 32 + crow(r, hh);
        const bool keep = dir ? (srow >= tcol) : (srow <= tcol);
        pm[r] = keep ? sc[r] : 0.f;
      }
#pragma unroll
      for (int ts = 0; ts < 2; ++ts) {
        const uint4 pk = pack8(pm + 8 * ts);
        const bf16x8 pf = __builtin_bit_cast(bf16x8, pk);
        const u16* vp = VT + (vt * 32 + l31) * 72 + sb * 32 + ts * 16 + hh * 4;
        const s16x4 lo = *(const s16x4*)vp;
        const s16x4 hi = *(const s16x4*)(vp + 8);
        const bf16x8 vf = __builtin_shufflevector(lo, hi, 0, 1, 2, 3, 4, 5, 6, 7);
        O = MFMA(vf, pf, O);
      }
    }
#pragma unroll
    for (int ks = 0; ks < 4; ++ks) {
      const bf16x8 bq = *(const bf16x8*)(Q2 + (tt * 32 + l31) * 72 + ks * 16 + hh * 8);
      O = MFMA(stf[dir][ks], bq, O);
    }
    __syncthreads();
  }
  float ss = 0.f;
#pragma unroll
  for (int r = 0; r < 16; ++r) ss += O[r] * O[r];
  ss += __shfl_xor(ss, 32);
  if (hh == 0) ssum[vt * 64 + tt * 32 + l31] = ss;
  __syncthreads();
  const float rr = rsqrtf((ssum[tt * 32 + l31] + ssum[64 + tt * 32 + l31]) * (1.f / 64.f) + EPS);
  const size_t tok = tok0 + tt * 32 + l31;
  const float* gon = p.in[17] + l * 64;
  uint2 hgv[4];
  float4 gv4[4];
#pragma unroll
  for (int i = 0; i < 4; ++i) {
    const int v0 = vt * 32 + 8 * i + 4 * hh;
    hgv[i] = *(const uint2*)(Z + tok * ZW + 2080 + h * 64 + v0);
    gv4[i] = *(const float4*)(gon + v0);
  }
#pragma unroll
  for (int i = 0; i < 4; ++i) {
    const int v0 = vt * 32 + 8 * i + 4 * hh;
    const uint2 hg = hgv[i];
    const float g0 = sigmoid_fast(bflo(hg.x)), g1 = sigmoid_fast(bfhi(hg.x));
    const float g2 = sigmoid_fast(bflo(hg.y)), g3 = sigmoid_fast(bfhi(hg.y));
    uint2 o;
    o.x = pack2(O[4 * i + 0] * rr * gv4[i].x * g0, O[4 * i + 1] * rr * gv4[i].y * g1);
    o.y = pack2(O[4 * i + 2] * rr * gv4[i].z * g2, O[4 * i + 3] * rr * gv4[i].w * g3);
    *(uint2*)(OH + tok * 256 + h * 64 + v0) = o;
  }
  __syncthreads();
}

DI void prep_diff(const Params& p, int l, int blk) {
  char* ws = lws(p.ws);
  const u16* Z = (const u16*)(ws + O_Z);
  const float* rc = (const float*)(ws + O_RC);
  const float* rs = (const float*)(ws + O_RS);
#pragma unroll
  for (int g = 0; g < 4; ++g) {
    const int isk = g >> 1;
    const int idx = tidx() + 256 * (g & 1);
    const int tl = idx >> 3, j = idx & 7;
    const int tok = blk * 64 + tl, b = tok >> 13, s = tok & 8191;
    const u16* src = Z + (size_t)tok * ZW + (isk ? 800 : 544) + j * 32;
    const float* gain = p.in[isk ? 10 : 9] + l * 32;
    float x[32];
#pragma unroll
    for (int i = 0; i < 4; ++i) unpack8(*(const uint4*)(src + 8 * i), x + 8 * i);
    float ss = 0.f;
#pragma unroll
    for (int i = 0; i < 32; ++i) ss += x[i] * x[i];
    const float r = rsqrtf(ss * (1.f / 32.f) + EPS);
#pragma unroll
    for (int i = 0; i < 32; ++i) x[i] = x[i] * r * gain[i];
    const float sc = isk ? 1.f : 0.17677669529663687f * LOG2E;
#pragma unroll
    for (int i = 0; i < 16; ++i) {
      const float c = rc[s * 16 + i], sn = rs[s * 16 + i];
      const float a = x[i], bb = x[i + 16];
      x[i] = (a * c - bb * sn) * sc;
      x[i + 16] = (a * sn + bb * c) * sc;
    }
    const int hd = j >> 1, mp = j & 1;
    u16* dst = (u16*)(ws + (isk ? O_KD : O_QD)) + ((((size_t)b * 4 + hd) * 2 + mp) * 8192 + s) * 32;
#pragma unroll
    for (int i = 0; i < 4; ++i) *(uint4*)(dst + 8 * i) = pack8(x + 8 * i);
  }
}

DI void prep_mla(const Params& p, int l, int blk) {
  char* ws = p.ws;
  const u16* Z = (const u16*)(ws + O_Z);
  const float* rc = (const float*)(ws + O_RC);
  const float* rs = (const float*)(ws + O_RS);
  const int tl = tidx() >> 2, hd = tidx() & 3;
  const int tok = blk * 64 + tl, b = tok >> 13, s = tok & 8191;
#pragma unroll 1
  for (int isk = 0; isk < 2; ++isk) {
    const u16* src0 = isk ? (const u16*)(ws + O_KN) + (size_t)tok * 256 + hd * 64 : (const u16*)(ws + O_QRAW) + (size_t)tok * 384 + hd * 96;
    const u16* src1 = isk ? Z + (size_t)tok * ZW + 512 : src0 + 64;
    const float* gain = p.in[isk ? 8 : 7] + l * 96;
    float ss = 0.f;
#pragma unroll
    for (int i = 0; i < 8; ++i) {
      float x[8]; unpack8(*(const uint4*)(src0 + 8 * i), x);
#pragma unroll
      for (int j = 0; j < 8; ++j) ss += x[j] * x[j];
    }
#pragma unroll
    for (int i = 0; i < 4; ++i) {
      float x[8]; unpack8(*(const uint4*)(src1 + 8 * i), x);
#pragma unroll
      for (int j = 0; j < 8; ++j) ss += x[j] * x[j];
    }
    const float r = rsqrtf(ss * (1.f / 96.f) + EPS);
    const float sc = isk ? 1.f : 0.10206207261596575f * LOG2E;
    const float rsc = r * sc;
    u16* dst = (u16*)(ws + (isk ? O_KM : O_QM)) + (((size_t)b * 4 + hd) * 8192 + s) * 96;
#pragma unroll
    for (int ib = 0; ib < 2; ++ib) {
      uint4 raw[4];
      float4 gq[8];
#pragma unroll
      for (int q = 0; q < 4; ++q) raw[q] = *(const uint4*)(src0 + 8 * (4 * ib + q));
#pragma unroll
      for (int q = 0; q < 8; ++q) gq[q] = *(const float4*)(gain + 32 * ib + 4 * q);
#pragma unroll
      for (int q = 0; q < 4; ++q) {
        const int i = 4 * ib + q;
        float x[8]; unpack8(raw[q], x);
        x[0] *= rsc * gq[2 * q].x; x[1] *= rsc * gq[2 * q].y; x[2] *= rsc * gq[2 * q].z; x[3] *= rsc * gq[2 * q].w;
        x[4] *= rsc * gq[2 * q + 1].x; x[5] *= rsc * gq[2 * q + 1].y; x[6] *= rsc * gq[2 * q + 1].z; x[7] *= rsc * gq[2 * q + 1].w;
        *(uint4*)(dst + 8 * i) = pack8(x);
      }
    }
    {
      uint4 raw[4];
      float4 gq[8], cq[4], sq[4];
#pragma unroll
      for (int q = 0; q < 4; ++q) raw[q] = *(const uint4*)(src1 + 8 * q);
#pragma unroll
      for (int q = 0; q < 8; ++q) gq[q] = *(const float4*)(gain + 64 + 4 * q);
#pragma unroll
      for (int q = 0; q < 4; ++q) { cq[q] = *(const float4*)(rc + s * 16 + 4 * q); sq[q] = *(const float4*)(rs + s * 16 + 4 * q); }
      const float* gqf = (const float*)gq;
      const float* cqf = (const float*)cq;
      const float* sqf = (const float*)sq;
#pragma unroll
      for (int i = 0; i < 2; ++i) {
        float xa[8], xb[8];
        unpack8(raw[i], xa);
        unpack8(raw[2 + i], xb);
#pragma unroll
        for (int j = 0; j < 8; ++j) {
          const int fi = 8 * i + j;
          const float c = cqf[fi], sn = sqf[fi];
          const float a = xa[j] * rsc * gqf[fi], bb = xb[j] * rsc * gqf[16 + fi];
          xa[j] = a * c - bb * sn;
          xb[j] = a * sn + bb * c;
        }
        *(uint4*)(dst + 64 + 8 * i) = pack8(xa);
        *(uint4*)(dst + 80 + 8 * i) = pack8(xb);
      }
    }
  }
}

#define SEG_LOOP(it, base, n) \
  _Pragma("unroll 1") for (int it = (int)((bidx() + VGRID - ((base) % VGRID)) % VGRID); it < (n); it += VGRID)

DI void ph_c(const Params& p, int l, u16* sm) {
  char* ws = lws(p.ws);
  const u16* Z = (const u16*)(ws + O_Z);
  float* rstd = (float*)((char*)sm + 73728);
  SEG_LOOP(it, 0, 768) {
    const int tn = it % 3, tm = it / 3;
    f32x16 acc[2][2]; zero_acc<2>(acc);
    const u16* A = Z + (size_t)tm * 128 * ZW;
    block_rstd(A, ZW, 384, rstd);
    gemm_ml<2, 2>(A, ZW, (const u16*)(ws + O_WUQ) + (size_t)tn * 128 * 384, 384, 384, acc, sm);
    u16* dst = (u16*)(ws + O_QRAW);
    epi<2>(acc, [&](int m, int n, float v) { dst[(size_t)(tm * 128 + m) * 384 + tn * 128 + n] = f2bf(v * rstd[m]); });
    __syncthreads();
  }
  SEG_LOOP(it, 768, 512) {
    const int tn = it & 1, tm = it >> 1;
    f32x16 acc[2][2]; zero_acc<2>(acc);
    const u16* A = Z + (size_t)tm * 128 * ZW + 384;
    block_rstd(A, ZW, 128, rstd);
    gemm_ml<2, 1>(A, ZW, (const u16*)(ws + O_WKN) + (size_t)tn * 128 * 128, 128, 128, acc, sm);
    u16* dst = (u16*)(ws + O_KN);
    epi<2>(acc, [&](int m, int n, float v) { dst[(size_t)(tm * 128 + m) * 256 + tn * 128 + n] = f2bf(v * rstd[m]); });
    __syncthreads();
  }
  SEG_LOOP(it, 1280, 512) {
    const int tmf = it & 1, nt = it >> 1;
    f32x16 acc[2][2]; zero_acc<2>(acc);
    const u16* B = Z + (size_t)nt * 128 * ZW + 384;
    block_rstd(B, ZW, 128, rstd);
    gemm_ml<2, 1>((const u16*)(ws + O_WV) + (size_t)tmf * 128 * 128, 128, B, ZW, 128, acc, sm);
    u16* dst = (u16*)(ws + O_VMT);
    epi<2>(acc, [&](int m, int n, float v) { dst[(size_t)(tmf * 128 + m) * T + nt * 128 + n] = f2bf(v * rstd[n]); });
    __syncthreads();
  }
  SEG_LOOP(it, 1792, 1024) {
    const int tmE = it & 1, tn = it >> 1;
    f32x16 acc[2][2]; zero_acc<2>(acc);
    gemm_ml<2, 1>((const u16*)(ws + O_E1) + (size_t)tmE * 128 * 128, 128, (const u16*)(ws + O_UT) + (size_t)tn * 128 * 128, 128, 128, acc, sm);
    u16* GT = (u16*)(ws + O_GT);
    const int lane = tidx() & 63, wave = tidx() >> 6, l31 = lane & 31, hh = lane >> 5, wm = wave >> 1, wn = wave & 1;
#pragma unroll
    for (int nt = 0; nt < 2; ++nt)
#pragma unroll
      for (int r = 0; r < 16; ++r) {
        const float re = acc[0][nt][r], im = acc[1][nt][r];
        const int p1 = tmE * 64 + wm * 32 + crow(r, hh);
        const int n = tn * 128 + wn * 64 + nt * 32 + l31;
        const int b = n >> 14, c = (n >> 6) & 255, s2 = n & 63;
        const float fr = (float)(s2 * p1) * (1.f / 8192.f);
        const float cs = __builtin_amdgcn_cosf(fr), sn = __builtin_amdgcn_sinf(fr);
        const float re2 = re * cs + im * sn, im2 = im * cs - re * sn;
        *(unsigned*)(GT + ((((size_t)(b * 128 + p1)) * 256 + c) * 64 + s2) * 2) = pack2(re2, im2);
      }
  }
  SEG_LOOP(it, 2816, 512) { prep_diff(p, l, it); }
  {
    const int g_ = VGRID;
    int it = (int)((bidx() + g_ - (3328 % g_)) % g_);
    u16 zc_[16], vc_[16];
    if (it < 4096) hgrn_h1_load(p, it, zc_, vc_);
#pragma unroll 1
    for (; it < 4096; it += g_) {
      u16 zn_[16], vn_[16];
      const int nx = it + g_;
      hgrn_h1_load(p, nx < 4096 ? nx : it, zn_, vn_);
      hgrn_h1(p, l, it, sm, zc_, vc_);
#pragma unroll
      for (int j = 0; j < 16; ++j) { zc_[j] = zn_[j]; vc_[j] = vn_[j]; }
    }
  }
}

DI void ph_d(const Params& p, int l, u16* sm) {
  char* ws = lws(p.ws);
  SEG_LOOP(tn, 0, 1024) {
    f32x16 acc[2][2]; zero_acc<2>(acc);
    gemm_ml<2, 1>((const u16*)(ws + O_E2), 128, (const u16*)(ws + O_GT) + (size_t)tn * 128 * 128, 128, 128, acc, sm);
    u16* OF = (u16*)(ws + O_OF);
    epi<2>(acc, [&](int m, int n, float v) {
      const int sel = m >> 6, p2 = m & 63;
      const int nn = tn * 128 + n;
      const int b = nn >> 15, p1 = (nn >> 8) & 127, c = nn & 255;
      const size_t tok = (size_t)b * 8192 + p1 + 128 * p2;
      OF[tok * 512 + sel * 256 + c] = f2bf(v);
    });
  }
  SEG_LOOP(it, 1024, 512) { prep_mla(p, l, it); }
  hgrn_h2(p);
}

template <int DK, int NMAP>
DI void attn_core(const u16* __restrict__ Qb, const u16* __restrict__ Kb, long mapstride, const u16* __restrict__ VTb, int q0,
                  f32x16 (&O)[NMAP][2], float (&ls)[NMAP], u16* sm) {
  constexpr int KS = DK / 16, KROW = DK + 8, KT_E = NMAP * 128 * KROW, VROW = 136, BUF = KT_E + 64 * VROW;
  constexpr int CPR = DK / 8;
  constexpr int CHM = 128 * CPR;
  constexpr int NKS = NMAP * CHM / 512;
  const int tid = rtid(), lane = tid & 63, wave = tid >> 6, l31 = lane & 31, hh = lane >> 5;
  bf16x8 qf[NMAP][KS];
  {
    const int query = q0 + wave * 32 + l31;
#pragma unroll
    for (int mp = 0; mp < NMAP; ++mp)
#pragma unroll
      for (int ks = 0; ks < KS; ++ks) qf[mp][ks] = *(const bf16x8*)(Qb + mp * mapstride + (long)query * DK + ks * 16 + hh * 8);
#pragma unroll
    for (int mp = 0; mp < NMAP; ++mp)
#pragma unroll
      for (int ks = 0; ks < KS; ++ks) asm volatile("" : "+v"(qf[mp][ks]));
  }
#pragma unroll
  for (int mp = 0; mp < NMAP; ++mp) {
    ls[mp] = 0.f;
#pragma unroll
    for (int dt = 0; dt < 2; ++dt)
#pragma unroll
      for (int r = 0; r < 16; ++r) O[mp][dt][r] = 0.f;
  }
  struct Stg { u32x4 k0, k1, k2, v0, v1; };
  Stg r0;
  const int g0 = tid, g1 = tid + 512, g2 = (NKS > 2) ? tid + 1024 : tid;
  const u16* gk0 = Kb + (g0 / CHM) * mapstride + (g0 % CHM) * 8;
  const u16* gk1 = Kb + (g1 / CHM) * mapstride + (g1 % CHM) * 8;
  const u16* gk2 = Kb + (g2 / CHM) * mapstride + (g2 % CHM) * 8;
  const int lk0 = ((g0 / CHM) * 128 + (g0 % CHM) / CPR) * KROW + ((g0 % CHM) % CPR) * 8;
  const int lk1 = ((g1 / CHM) * 128 + (g1 % CHM) / CPR) * KROW + ((g1 % CHM) % CPR) * 8;
  const int lk2 = ((g2 / CHM) * 128 + (g2 % CHM) / CPR) * KROW + ((g2 % CHM) % CPR) * 8;
  const u16* gv0 = VTb + (long)(g0 >> 4) * T + (g0 & 15) * 8;
  const u16* gv1 = VTb + (long)(g1 >> 4) * T + (g1 & 15) * 8;
  const int lv0 = (g0 >> 4) * VROW + ((g0 & 15) >> 1) * 16 + (g0 & 1) * 4;
  const int lv1 = (g1 >> 4) * VROW + ((g1 & 15) >> 1) * 16 + (g1 & 1) * 4;
#define AGL(R, kt_)                                              \
  {                                                              \
    const long ko = (long)(kt_) * 128 * DK;                      \
    R.k0 = *(const u32x4*)(gk0 + ko);                            \
    R.k1 = *(const u32x4*)(gk1 + ko);                            \
    if (NKS > 2) R.k2 = *(const u32x4*)(gk2 + ko);               \
    R.v0 = *(const u32x4*)(gv0 + (kt_) * 128);                   \
    R.v1 = *(const u32x4*)(gv1 + (kt_) * 128);                   \
  }
#define ASW(R, buf_)                                             \
  {                                                              \
    u16* ks_ = sm + (buf_) * BUF;                                \
    u16* vs_ = ks_ + KT_E;                                       \
    *(u32x4*)(ks_ + lk0) = R.k0;                                 \
    *(u32x4*)(ks_ + lk1) = R.k1;                                 \
    if (NKS > 2) *(u32x4*)(ks_ + lk2) = R.k2;                    \
    *(uint2*)(vs_ + lv0) = make_uint2(R.v0[0], R.v0[1]);         \
    *(uint2*)(vs_ + lv0 + 8) = make_uint2(R.v0[2], R.v0[3]);     \
    *(uint2*)(vs_ + lv1) = make_uint2(R.v1[0], R.v1[1]);         \
    *(uint2*)(vs_ + lv1 + 8) = make_uint2(R.v1[2], R.v1[3]);     \
  }
  auto compute = [&](int buf) {
    const u16* ks_ = sm + buf * BUF;
    const u16* vs_ = ks_ + KT_E;
    auto qk = [&](int u, f32x16& s) {
      const int sb = u / NMAP, mp = u % NMAP;
#pragma unroll
      for (int r = 0; r < 16; ++r) s[r] = 0.f;
#pragma unroll
      for (int ks = 0; ks < KS; ++ks) {
        const bf16x8 kf = *(const bf16x8*)(ks_ + (mp * 128 + sb * 32 + l31) * KROW + ks * 16 + hh * 8);
        s = MFMA(kf, qf[mp][ks], s);
      }
    };
    auto smpv = [&](int u, f32x16& s) {
      const int sb = u / NMAP, mp = u % NMAP;
      float pr[16];
      float a0 = 0.f, a1 = 0.f, a2 = 0.f, a3 = 0.f;
#pragma unroll
      for (int r = 0; r < 16; r += 4) {
        pr[r] = __builtin_amdgcn_exp2f(s[r]); a0 += pr[r];
        pr[r + 1] = __builtin_amdgcn_exp2f(s[r + 1]); a1 += pr[r + 1];
        pr[r + 2] = __builtin_amdgcn_exp2f(s[r + 2]); a2 += pr[r + 2];
        pr[r + 3] = __builtin_amdgcn_exp2f(s[r + 3]); a3 += pr[r + 3];
      }
      ls[mp] += (a0 + a1) + (a2 + a3);
      bf16x8 pf[2];
      pf[0] = __builtin_bit_cast(bf16x8, pack8(pr));
      pf[1] = __builtin_bit_cast(bf16x8, pack8(pr + 8));
#pragma unroll
      for (int ts = 0; ts < 2; ++ts)
#pragma unroll
        for (int dt = 0; dt < 2; ++dt) {
          const bf16x8 vf = *(const bf16x8*)(vs_ + (dt * 32 + l31) * VROW + sb * 32 + ts * 16 + hh * 8);
          O[mp][dt] = MFMA(vf, pf[ts], O[mp][dt]);
        }
    };
    f32x16 sA, sB;
    qk(0, sA);
    if (NMAP == 1) {
#pragma unroll
      for (int u = 0; u < 4; ++u) {
        if (u + 1 < 4) qk(u + 1, (u & 1) ? sA : sB);
        smpv(u, (u & 1) ? sB : sA);
      }
    } else {
#pragma unroll 1
      for (int sb = 0; sb < 4; ++sb) {
        qk(sb * NMAP + 1, sB);
        smpv(sb * NMAP, sA);
        qk(((sb + 1) & 3) * NMAP, sA);
        smpv(sb * NMAP + 1, sB);
      }
    }
  };
  constexpr int NKT = SEQ / 128;
  AGL(r0, 0);
  ASW(r0, 0);
  __syncthreads();
  if (wave >= 4) __builtin_amdgcn_s_setprio(1);
#pragma unroll 1
  for (int kt = 0; kt < NKT; ++kt) {
    const int buf = kt & 1;
    if (kt + 1 < NKT) AGL(r0, kt + 1);
    compute(buf);
    if (kt + 1 < NKT) ASW(r0, buf ^ 1);
    __syncthreads();
  }
#undef AGL
#undef ASW
  __builtin_amdgcn_s_setprio(0);
#pragma unroll
  for (int mp = 0; mp < NMAP; ++mp) ls[mp] += __shfl_xor(ls[mp], 32);
}

DI void attn_mla(const Params& p, int l, int id, u16* sm) {
  char* ws = lws(p.ws);
  const int lane = rtid() & 63, wave = rtid() >> 6, l31 = lane & 31, hh = lane >> 5;
  const int bh = id >> 5, qb = id & 31, b = bh >> 2, hd = bh & 3;
  const int q0 = qb * 256;
  const size_t tok = (size_t)b * 8192 + q0 + wave * 32 + l31;
  f32x16 O[1][2];
  float ls[1];
  attn_core<96, 1>((const u16*)(ws + O_QM) + (size_t)bh * 8192 * 96, (const u16*)(ws + O_KM) + (size_t)bh * 8192 * 96, 0,
                   (const u16*)(ws + O_VMT) + (size_t)(hd * 64) * T + (size_t)b * 8192, q0, O, ls, sm);
  const float inv = 1.f / ls[0];
  u16* dst = (u16*)(ws + O_OM) + tok * 256 + hd * 64;
#pragma unroll
  for (int dt = 0; dt < 2; ++dt)
#pragma unroll
    for (int i = 0; i < 4; ++i) {
      uint2 o;
      o.x = pack2(O[0][dt][4 * i] * inv, O[0][dt][4 * i + 1] * inv);
      o.y = pack2(O[0][dt][4 * i + 2] * inv, O[0][dt][4 * i + 3] * inv);
      *(uint2*)(dst + dt * 32 + 8 * i + 4 * hh) = o;
    }
}

DI void attn_diff(const Params& p, int l, int id, u16* sm) {
  char* ws = lws(p.ws);
  const int lane = rtid() & 63, wave = rtid() >> 6, l31 = lane & 31, hh = lane >> 5;
  const int bh = id >> 5, qb = id & 31, b = bh >> 2, hd = bh & 3;
  const int q0 = qb * 256;
  const size_t tok = (size_t)b * 8192 + q0 + wave * 32 + l31;
  f32x16 O[2][2];
  float ls[2];
  attn_core<32, 2>((const u16*)(ws + O_QD) + (size_t)bh * 2 * 8192 * 32, (const u16*)(ws + O_KD) + (size_t)bh * 2 * 8192 * 32,
                   8192 * 32, (const u16*)(ws + O_VDT) + (size_t)(hd * 64) * T + (size_t)b * 8192, q0, O, ls, sm);
  float d1 = 0.f, d2 = 0.f;
  for (int i = 0; i < 32; ++i) {
    d1 += p.in[11][l * 32 + i] * p.in[12][l * 32 + i];
    d2 += p.in[13][l * 32 + i] * p.in[14][l * 32 + i];
  }
  const float lam_init = 0.8f - 0.6f * expf(-0.3f * (float)l);
  const float lam = expf(d1) - expf(d2) + lam_init;
  const float i1 = 1.f / ls[0], i2 = lam / ls[1];
  float ss = 0.f;
#pragma unroll
  for (int dt = 0; dt < 2; ++dt)
#pragma unroll
    for (int r = 0; r < 16; ++r) {
      const float v = O[0][dt][r] * i1 - O[1][dt][r] * i2;
      O[0][dt][r] = v;
      ss += v * v;
    }
  ss += __shfl_xor(ss, 32);
  const float rr = rsqrtf(ss * (1.f / 64.f) + EPS) * (1.f - lam_init);
  const float* gs = p.in[15] + l * 64;
  u16* dst = (u16*)(ws + O_OD) + tok * 256 + hd * 64;
  float4 gsv[2][4];
#pragma unroll
  for (int dt = 0; dt < 2; ++dt)
#pragma unroll
    for (int i = 0; i < 4; ++i) gsv[dt][i] = *(const float4*)(gs + dt * 32 + 8 * i + 4 * hh);
#pragma unroll
  for (int dt = 0; dt < 2; ++dt)
#pragma unroll
    for (int i = 0; i < 4; ++i) {
      const int d0 = dt * 32 + 8 * i + 4 * hh;
      uint2 o;
      o.x = pack2(O[0][dt][4 * i] * rr * gsv[dt][i].x, O[0][dt][4 * i + 1] * rr * gsv[dt][i].y);
      o.y = pack2(O[0][dt][4 * i + 2] * rr * gsv[dt][i].z, O[0][dt][4 * i + 3] * rr * gsv[dt][i].w);
      *(uint2*)(dst + d0) = o;
    }
}

DI void ph_e(const Params& p, int l, u16* sm, u16* sm_all) {
#ifndef NO_MLA
#pragma unroll 1
  for (int it = rbid(); it < 512; it += (int)gridDim.x) {
    const int xcd = it & 7, q = it >> 3, grp = q >> 5, j = q & 31;
    attn_mla(p, l, (grp * 8 + xcd) * 32 + j, sm_all);
  }
#endif
#ifndef NO_DIFF
#pragma unroll 1
  for (int it = rbid(); it < 512; it += (int)gridDim.x) {
    const int xcd = it & 7, q = it >> 3, grp = q >> 5, j = q & 31;
    attn_diff(p, l, (grp * 8 + xcd) * 32 + j, sm_all);
  }
#endif
#ifndef NO_H3
  SEG_LOOP(it, 0, 2048) { hgrn_h3(p, l, it, sm); }
#endif
}

DI void ph_merge(const Params& p, u16* sm) {
  char* ws = lws(p.ws);
  const u16* G = (const u16*)(ws + O_G);
  u16* MG = (u16*)(ws + O_MG);
  const int lane = tidx() & 63, wave = tidx() >> 6, l31 = lane & 31, hh = lane >> 5, wm = wave >> 1, wn = wave & 1;
#pragma unroll 1
  for (int it = bidx(); it < 256 * 8; it += VGRID) {
    const int tn = it & 7, tm = it >> 3;
    f32x16 mg[2][2];
    zero_acc<2>(mg);
#pragma unroll 1
    for (int n = 0; n < 4; ++n) {
      f32x16 ab[2][2];
      zero_acc<2>(ab);
      const size_t oa = n == 0 ? O_OM : (n == 1 ? O_OF : (n == 2 ? O_OD : O_OH));
      const size_t ob = n == 0 ? O_WB0 : (n == 1 ? O_WB1 : (n == 2 ? O_WB2 : O_WB3));
      const int kn = n == 1 ? 512 : 256;
      gemm_ml<2, 2>((const u16*)(ws + oa) + (size_t)tm * 128 * kn, kn, (const u16*)(ws + ob) + (size_t)tn * 128 * kn, kn, kn, ab, sm);
      const u16* gp = G + (size_t)(tm * 128 + wm * 64 + 4 * hh) * 4096 + n * 1024 + tn * 128 + wn * 64 + l31;
#pragma unroll
      for (int mt = 0; mt < 2; ++mt)
#pragma unroll
        for (int nt = 0; nt < 2; ++nt)
#pragma unroll
          for (int r = 0; r < 16; ++r) {
            const float g = bf2f(gp[(size_t)(mt * 32 + (r & 3) + 8 * (r >> 2)) * 4096 + nt * 32]);
            mg[mt][nt][r] += g * ab[mt][nt][r];
          }
    }
    epi<2>(mg, [&](int m, int n, float v) { MG[(size_t)(tm * 128 + m) * 1024 + tn * 128 + n] = f2bf(v); });
  }
}

#define XB_TMO      128
#define XB_XCNT(j)  (256  + 64 * (j))
#define XB_XSUB(j)  (1280 + 64 * (j))
#define XB_XGEN(j)  (2304 + 64 * (j))
#define XB_TOP      3328
#define XB_TOPGEN   3392
#define XCD_BAR_WORDS 3456
#define XB_SPIN_CAP (1u << 18)
#define XLAS __attribute__((address_space(3)))

__device__ __forceinline__ unsigned xb_ld(unsigned* p)              { return __hip_atomic_load(p, __ATOMIC_RELAXED, __HIP_MEMORY_SCOPE_AGENT); }
__device__ __forceinline__ unsigned xb_add(unsigned* p, unsigned v) { return __hip_atomic_fetch_add(p, v, __ATOMIC_RELAXED, __HIP_MEMORY_SCOPE_AGENT); }
__device__ __forceinline__ unsigned xb_xcc_id() { return (unsigned)__builtin_amdgcn_s_getreg((3 << 11) | 20) & 0xFu; }
#define XB_SPIN(cond, bar) do { unsigned _sp = 0; while (cond) { __builtin_amdgcn_s_sleep(1); \
    if ((++_sp & 255u) == 0u) { if (xb_ld(&(bar)[XB_TMO])) break; if (_sp > XB_SPIN_CAP) { atomicAdd(&(bar)[XB_TMO], 1u); break; } } } } while (0)

struct XcdBarrier {
    unsigned* bar; unsigned x;
    volatile XLAS unsigned* st;
};

__device__ __forceinline__ XcdBarrier xcd_barrier_post(unsigned* bar, volatile XLAS unsigned* st) {
    XcdBarrier b; b.bar = bar; b.x = xb_xcc_id(); b.st = st;
    if (threadIdx.x == 0) (void)xb_add(&bar[XB_XCNT(b.x)], 1u);
    return b;
}
__device__ __forceinline__ void xcd_barrier_complete(unsigned* bar, unsigned x, unsigned& nloc, unsigned& nx) {
    const unsigned G = gridDim.x * gridDim.y * gridDim.z;
    unsigned sum, cnt, mine, sp = 0u;
    for (;;) {
        sum = 0u; cnt = 0u; mine = 0u;
#pragma unroll
        for (unsigned j = 0; j < 16; ++j) { const unsigned c = xb_ld(&bar[XB_XCNT(j)]); sum += c; cnt += (c > 0u) ? 1u : 0u; mine = (j == x) ? c : mine; }
        if (sum == G) break;
        __builtin_amdgcn_s_sleep(1);
        if ((++sp & 255u) == 0u) { if (xb_ld(&bar[XB_TMO])) break; if (sp > XB_SPIN_CAP) { atomicAdd(&bar[XB_TMO], 1u); break; } }
    }
    nloc = mine > 0u ? mine : 1u; nx = cnt > 0u ? cnt : 1u;
}

__device__ __forceinline__ void xcd_barrier(const XcdBarrier& b) {
    asm volatile("s_waitcnt vmcnt(0)" ::: "memory");
    __syncthreads();
    if (threadIdx.x == 0) {
        unsigned* bar = b.bar;
        __builtin_amdgcn_s_waitcnt(0);
        unsigned nloc = b.st[0], nx = b.st[1];
        if (nloc == 0u) { xcd_barrier_complete(bar, b.x, nloc, nx); b.st[0] = nloc; b.st[1] = nx; }
        const unsigned old = xb_add(&bar[XB_XSUB(b.x)], 1u);
        const unsigned gen = old / nloc;
        if (old + 1u == (gen + 1u) * nloc) {
            __builtin_amdgcn_fence(__ATOMIC_RELEASE, "agent");
            asm volatile("s_waitcnt vmcnt(0)" ::: "memory");
            const unsigned og = xb_add(&bar[XB_TOP], 1u);
            const unsigned tg = og / nx;
            if (og + 1u == (tg + 1u) * nx) xb_add(&bar[XB_TOPGEN], 1u);
            else XB_SPIN(xb_ld(&bar[XB_TOPGEN]) == tg, bar);
            __builtin_amdgcn_fence(__ATOMIC_ACQUIRE, "agent");
            xb_add(&bar[XB_XGEN(b.x)], 1u);
            asm volatile("s_waitcnt vmcnt(0)" ::: "memory");
        } else {
            XB_SPIN(xb_ld(&bar[XB_XGEN(b.x)]) == gen, bar);
            __builtin_amdgcn_fence(__ATOMIC_ACQUIRE, "agent");
            asm volatile("s_waitcnt vmcnt(0)" ::: "memory");
        }
    }
    __syncthreads();
}


constexpr int NPH = 11;
#ifndef LB_MIN
#define LB_MIN 2
#endif

template <bool COOP>
__global__ void __launch_bounds__(512, LB_MIN) mk(Params p, int ph_lo, int ph_hi) {
  __shared__ __attribute__((aligned(16))) u16 sm_all[SMEM_BYTES + 8];
  u16* sm = sm_all + __builtin_amdgcn_readfirstlane((int)(threadIdx.x >> 8)) * (SMEM_BYTES / 2);
#ifndef PROBE_MASK
#define PROBE_MASK 0
#endif
  int rr = 0;
  (void)rr;
  if (threadIdx.x == 0) *(uint4*)(sm_all + SMEM_BYTES) = make_uint4(0u, 0u, 0u, 0u);
  __syncthreads();
  XcdBarrier xb = xcd_barrier_post((unsigned*)(p.ws + O_BAR), (volatile XLAS unsigned*)(sm_all + SMEM_BYTES));
  for (int ph = ph_lo; ph < ph_hi; ++ph) {
    const int l = ph / NPH, s = ph % NPH;
    char* ws = lws(p.ws);
    const float* xin = l == 0 ? p.in[0] : p.out;
#ifndef ONLY_PHASE
#define ONLY_PHASE -1
#endif
#define PH_ON(x) (ONLY_PHASE < 0 || ONLY_PHASE == (x))
    switch (s) {
      case 0:
        if (!PH_ON(0)) break;
        ph_wprep(p, l);
        ph_rmsnorm(xin, p.in[1] + l * 1024, (u16*)(ws + O_H));
        break;
      case 1:
        if (PH_ON(1)) {
          run_gemm8(sm_all, (const u16*)(ws + O_H), (const u16*)(ws + O_WZ), T, 2560, 1024, EpiZ{(u16*)(ws + O_Z)});
          if ((int)gridDim.x == 256) {
            pg8::Gemm g;
            g.A = (const u16*)(ws + O_WF); g.Bt = (const u16*)(ws + O_H); g.M = 512; g.N = T; g.K = 1024;
            FeatOrder S;
            S.c = (int)blockIdx.x;
            pg8::gemm_phase<EpiFeat, FeatOrder, false>((PG8_LAS unsigned char*)sm_all, g, S, EpiFeat{(u16*)(ws + O_UT), (u16*)(ws + O_VDT)}, nullptr);
          } else {
            ph_inproj(p, sm);
          }
        }
        break;
      case 2: if (PH_ON(2)) ph_c(p, l, sm); break;
      case 3: if (PH_ON(3)) ph_d(p, l, sm); break;
      case 4: if (PH_ON(4)) ph_e(p, l, sm, sm_all); break;
      case 5: if (PH_ON(5)) run_gemm8(sm_all, (const u16*)(ws + O_H), (const u16*)(ws + O_WG), T, 4096, 1024, EpiSig{(u16*)(ws + O_G)}); break;
      case 6:
        if (PH_ON(6)) {
          const u16* Gb = (const u16*)(ws + O_G);
          u16* MGb = (u16*)(ws + O_MG);
#pragma unroll 1
          for (int n = 0; n < 4; ++n) {
            const size_t oa = n == 0 ? O_OM : (n == 1 ? O_OF : (n == 2 ? O_OD : O_OH));
            const size_t ob = n == 0 ? O_WB0 : (n == 1 ? O_WB1 : (n == 2 ? O_WB2 : O_WB3));
            run_gemm8(sm_all, (const u16*)(ws + oa), (const u16*)(ws + ob), T, 1024, n == 1 ? 512 : 256, EpiMrg{Gb + n * 1024, MGb, n == 0});
          }
        }
        break;
      case 7: if (PH_ON(7)) run_gemm8(sm_all, (const u16*)(ws + O_MG), (const u16*)(ws + O_WO), T, 1024, 1024, EpiRes{xin, p.out}); break;
      case 8: if (PH_ON(8)) ph_rmsnorm(p.out, p.in[20] + l * 1024, (u16*)(ws + O_H)); break;
      case 9: if (PH_ON(9)) run_gemm8(sm_all, (const u16*)(ws + O_H), (const u16*)(ws + O_WGU), T, 5632, 1024, EpiSwi{(u16*)(ws + O_ACT)}); break;
      case 10: if (PH_ON(10)) run_gemm8(sm_all, (const u16*)(ws + O_ACT), (const u16*)(ws + O_WD), T, 1024, DFF, EpiRes{p.out, p.out}); break;
    }
    if (COOP) {
      if (ph + 1 < ph_hi) {
        if (ph_hi > 100000) cg::this_grid().sync();
        xcd_barrier(xb);
      }
    }
#if PROBE_MASK
    if (COOP && rr == 0 && ph < NPH && ((PROBE_MASK >> ph) & 1)) { rr = 1; --ph; } else rr = 0;
#endif
  }
}

extern "C" void kernel_launch(void* const* d_in, const int* in_sizes, int n_in, void* d_out, int out_size, void* d_ws,
                              size_t ws_size, hipStream_t stream) {
  Params p{};
  for (int i = 0; i < 23; ++i) p.in[i] = (const float*)d_in[i];
  p.out = (float*)d_out;
  p.ws = (char*)d_ws;
  if (ws_size < O_END2) fprintf(stderr, "workspace too small: %zu < %zu\n", ws_size, (size_t)O_END2);
  hipMemsetAsync((char*)d_ws + O_BAR, 0, 16384, stream);
  static int grid_blocks = 0;
  if (!grid_blocks) {
    int dev = 0, cus = 0, per_cu = 0;
    hipGetDevice(&dev);
    hipDeviceGetAttribute(&cus, hipDeviceAttributeMultiprocessorCount, dev);
#if MK_ONE_LAUNCH
    hipOccupancyMaxActiveBlocksPerMultiprocessor(&per_cu, mk<true>, 512, 0);
#else
    hipOccupancyMaxActiveBlocksPerMultiprocessor(&per_cu, mk<false>, 512, 0);
#endif
    if (per_cu < 1) per_cu = 1;
    if (per_cu > 1) per_cu = 1;
    grid_blocks = cus * per_cu;
  }
#if MK_ONE_LAUNCH
  int lo = 0, hi = 2 * NPH;
  void* args[] = {&p, &lo, &hi};
  hipError_t e = hipLaunchCooperativeKernel((void*)mk<true>, dim3(grid_blocks), dim3(512), args, 0, stream);
  if (e != hipSuccess) fprintf(stderr, "cooperative launch failed: %s (grid %d)\n", hipGetErrorString(e), grid_blocks);
#else
  for (int ph = 0; ph < 2 * NPH; ++ph) mk<false><<<grid_blocks, 512, 0, stream>>>(p, ph, ph + 1);
#endif
}
```
